# Optimizing an MI355X kernel written in HIP

```python
import jax, jax.numpy as jnp
from jax import lax
import numpy as np

D_MODEL = 2048
BATCH = 4
SEQ = 4096
DEPTH = 1
DEC_BATCH = 32
DEC_SEQ = 32
PAST_LEN = 2048

CHUNK = 64
N_MEM = 256
POOL_WINDOWS = (2, 4, 8, 16)
POOL_GROUPS = 4
POOL_WIDTH = D_MODEL // 4
POOL_GDIM = POOL_WIDTH // POOL_GROUPS
POOL_STATE = 15
GLA_HEADS = 4
GLA_VDIM = D_MODEL // 2
GLA_KDIM = GLA_VDIM // 2
GLA_HK = GLA_KDIM // GLA_HEADS
GLA_HV = GLA_VDIM // GLA_HEADS
GLA_GATE_RANK = 16
GLA_TAU = 16.0
MEM_HEADS = 4
MEM_WIDTH = D_MODEL // 4
MEM_HD = MEM_WIDTH // MEM_HEADS
D_FF = 5632
CONV_W = 3
N_BRANCH = 3
EPS = 1e-6
IN_SIZES = (POOL_WIDTH, GLA_KDIM, GLA_KDIM, GLA_VDIM, GLA_VDIM, GLA_GATE_RANK, MEM_WIDTH)
IN_WIDTH = POOL_WIDTH + 2 * GLA_KDIM + 2 * GLA_VDIM + GLA_GATE_RANK + MEM_WIDTH

kernel_name = 'hybrid_pool_gla_memory_streaming_step'


def rmsnorm(x, g):
    xf = x.astype(jnp.float32)
    y = xf * lax.rsqrt(jnp.mean(xf * xf, axis=-1, keepdims=True) + EPS)
    return (y * g.astype(jnp.float32)).astype(x.dtype)


def pool_mixer(u, hist, start_pos, w_pool, s_pool):
    B, T, P = u.shape
    full = jnp.concatenate([hist, u], axis=1)
    cs = jnp.cumsum(full.astype(jnp.float32), axis=1)
    cs = jnp.pad(cs, ((0, 0), (1, 0), (0, 0)))
    L = POOL_STATE
    pos = start_pos + jnp.arange(T)
    end = cs[:, L + 1:L + 1 + T]
    outs = []
    for g, w in enumerate(POOL_WINDOWS):
        sl = slice(g * POOL_GDIM, (g + 1) * POOL_GDIM)
        begin = cs[:, L + 1 - w:L + 1 - w + T, sl]
        cnt = jnp.minimum(pos + 1, w).astype(jnp.float32)[None, :, None]
        mean = (end[..., sl] - begin) / cnt
        outs.append(mean.astype(u.dtype) - u[..., sl])
    d = jnp.stack(outs, axis=2)
    y = jnp.einsum('btgc,gcd->btgd', d, w_pool).reshape(B, T, P) * s_pool
    return y, full[:, -POOL_STATE:]


def gla_chunked(q, k, v, log_a, s0):
    B, T, H, dk = q.shape
    dv = v.shape[-1]
    C = CHUNK if T % CHUNK == 0 else T
    N = T // C
    f32 = jnp.float32
    qc = q.astype(f32).reshape(B, N, C, H, dk) * (dk ** -0.5)
    kc = k.astype(f32).reshape(B, N, C, H, dk)
    vc = v.astype(f32).reshape(B, N, C, H, dv)
    b = jnp.cumsum(log_a.reshape(B, N, C, H, dk), axis=2)
    b_last = b[:, :, -1]
    q_e = qc * jnp.exp(b)
    k_e = kc * jnp.exp(-b)
    k_tail = kc * jnp.exp(b_last[:, :, None] - b)
    causal = jnp.tril(jnp.ones((C, C), dtype=bool))
    att = jnp.where(causal, jnp.einsum('bnihk,bnjhk->bnhij', q_e, k_e), 0.0)
    o_intra = jnp.einsum('bnhij,bnjhv->bnihv', att, vc)
    kv = jnp.einsum('bnjhk,bnjhv->nbhkv', k_tail, vc)
    decay = jnp.exp(b_last).transpose(1, 0, 2, 3)

    def step(s, inp):
        dec, kv_n = inp
        return dec[..., None] * s + kv_n, s

    s_final, s_starts = lax.scan(step, s0.astype(f32), (decay, kv))
    o_inter = jnp.einsum('bnihk,nbhkv->bnihv', q_e, s_starts)
    o = (o_intra + o_inter).reshape(B, T, H, dv).astype(q.dtype)
    return o, s_final


def memory_kv(mem, g_mem, w_mem_k, w_mem_v):
    B = mem.shape[0]
    m = rmsnorm(mem, g_mem)
    k = (m @ w_mem_k).reshape(B, N_MEM, MEM_HEADS, MEM_HD)
    v = (m @ w_mem_v).reshape(B, N_MEM, MEM_HEADS, MEM_HD)
    return k, v


def memory_attend(q, k, v):
    s = jnp.einsum('bthd,bmhd->bhtm', q, k).astype(jnp.float32) * (MEM_HD ** -0.5)
    p = jax.nn.softmax(s, axis=-1).astype(v.dtype)
    return jnp.einsum('bhtm,bmhd->bthd', p, v)


def conv_ffn(x, hist, w_up, w_dw, b_dw, w_down):
    T = x.shape[1]
    a = x @ w_up
    full = jnp.concatenate([hist, a], axis=1)
    c = full[:, 0:T] * w_dw[0]
    for j in range(1, CONV_W):
        c = c + full[:, j:j + T] * w_dw[j]
    c = c + b_dw
    g, val = jnp.split(c, 2, axis=-1)
    y = (jax.nn.gelu(g) * val) @ w_down
    return y, full[:, -(CONV_W - 1):]


def layer(x, mem_k, mem_v, pool_hist, gla_s, conv_hist, start_pos,
          g_pre_mix, w_in, w_pool, s_pool, w_gla_gate, b_gla_gate, g_gla_head,
          w_gate, b_gate, w_b_pool, w_b_gla, w_b_mem, w_o, g_post_mix,
          g_pre_ffn, w_up, w_dw, b_dw, w_down, g_post_ffn):
    B, T, _ = x.shape
    h = rmsnorm(x, g_pre_mix)
    z = h @ w_in
    u, q, k, v, r, a_lr, mq = jnp.split(z, np.cumsum(IN_SIZES)[:-1].tolist(), axis=-1)
    y_pool, new_pool = pool_mixer(u, pool_hist, start_pos, w_pool, s_pool)
    log_a = jax.nn.log_sigmoid((a_lr @ w_gla_gate + b_gla_gate).astype(jnp.float32)) / GLA_TAU
    o, new_s = gla_chunked(q.reshape(B, T, GLA_HEADS, GLA_HK), k.reshape(B, T, GLA_HEADS, GLA_HK),
                           v.reshape(B, T, GLA_HEADS, GLA_HV),
                           log_a.reshape(B, T, GLA_HEADS, GLA_HK), gla_s)
    o = rmsnorm(o, g_gla_head).reshape(B, T, GLA_VDIM) * jax.nn.silu(r)
    m = memory_attend(mq.reshape(B, T, MEM_HEADS, MEM_HD), mem_k, mem_v).reshape(B, T, MEM_WIDTH)
    gates = jax.nn.sigmoid(h @ w_gate + b_gate).reshape(B, T, N_BRANCH, D_MODEL)
    merged = (gates[:, :, 0] * (y_pool @ w_b_pool) + gates[:, :, 1] * (o @ w_b_gla)
              + gates[:, :, 2] * (m @ w_b_mem))
    x = x + rmsnorm(merged @ w_o, g_post_mix)
    f, new_conv = conv_ffn(rmsnorm(x, g_pre_ffn), conv_hist, w_up, w_dw, b_dw, w_down)
    x = x + rmsnorm(f, g_post_ffn)
    return x, new_pool, new_s, new_conv


def setup_inputs(seed: int = 0) -> dict:
    key = jax.random.key(seed)
    ks = iter(jax.random.split(key, 40))

    def nrm(shape, scale=1.0):
        return jax.random.normal(next(ks), shape, jnp.float32) * scale

    def gain(shape):
        return 1.0 + nrm(shape, 0.02)

    L = DEPTH
    F2 = 2 * D_FF
    return {
        'x_prompt': nrm((BATCH, SEQ, D_MODEL)),
        'x_sample': nrm((DEC_BATCH, DEC_SEQ, D_MODEL)),
        'mem_prompt': nrm((BATCH, N_MEM, D_MODEL)),
        'cache_pool': nrm((L, DEC_BATCH, POOL_STATE, POOL_WIDTH)),
        'state_gla': nrm((L, DEC_BATCH, GLA_HEADS, GLA_HK, GLA_HV)),
        'cache_ffn_conv': nrm((L, DEC_BATCH, CONV_W - 1, F2)),
        'cache_mem_k': nrm((L, DEC_BATCH, N_MEM, MEM_HEADS, MEM_HD)),
        'cache_mem_v': nrm((L, DEC_BATCH, N_MEM, MEM_HEADS, MEM_HD)),
        'g_mem': gain((L, D_MODEL)),
        'w_mem_k': nrm((L, D_MODEL, MEM_WIDTH), D_MODEL ** -0.5),
        'w_mem_v': nrm((L, D_MODEL, MEM_WIDTH), D_MODEL ** -0.5),
        'g_pre_mix': gain((L, D_MODEL)),
        'w_in': nrm((L, D_MODEL, IN_WIDTH), D_MODEL ** -0.5),
        'w_pool': nrm((L, POOL_GROUPS, POOL_GDIM, POOL_GDIM), POOL_GDIM ** -0.5),
        's_pool': gain((L, POOL_WIDTH)),
        'w_gla_gate': nrm((L, GLA_GATE_RANK, GLA_KDIM), GLA_GATE_RANK ** -0.5),
        'b_gla_gate': nrm((L, GLA_KDIM), 0.1),
        'g_gla_head': gain((L, GLA_HEADS, GLA_HV)),
        'w_gate': nrm((L, D_MODEL, N_BRANCH * D_MODEL), D_MODEL ** -0.5),
        'b_gate': nrm((L, N_BRANCH * D_MODEL), 0.01),
        'w_b_pool': nrm((L, POOL_WIDTH, D_MODEL), POOL_WIDTH ** -0.5),
        'w_b_gla': nrm((L, GLA_VDIM, D_MODEL), GLA_VDIM ** -0.5),
        'w_b_mem': nrm((L, MEM_WIDTH, D_MODEL), MEM_WIDTH ** -0.5),
        'w_o': nrm((L, D_MODEL, D_MODEL), D_MODEL ** -0.5),
        'g_post_mix': gain((L, D_MODEL)),
        'g_pre_ffn': gain((L, D_MODEL)),
        'w_up': nrm((L, D_MODEL, F2), D_MODEL ** -0.5),
        'w_dw': nrm((L, CONV_W, F2), CONV_W ** -0.5),
        'b_dw': nrm((L, F2), 0.01),
        'w_down': nrm((L, D_FF, D_MODEL), D_FF ** -0.5),
        'g_post_ffn': gain((L, D_MODEL)),
    }


def reference(x_prompt, x_sample, mem_prompt, cache_pool, state_gla, cache_ffn_conv,
              cache_mem_k, cache_mem_v, g_mem, w_mem_k, w_mem_v, g_pre_mix, w_in, w_pool,
              s_pool, w_gla_gate, b_gla_gate, g_gla_head, w_gate, b_gate, w_b_pool, w_b_gla,
              w_b_mem, w_o, g_post_mix, g_pre_ffn, w_up, w_dw, b_dw, w_down, g_post_ffn):
    yp = x_prompt
    ys = x_sample
    bp = x_prompt.shape[0]
    pool_p, pool_s, gla_p, gla_s, conv_p, conv_s, memk_p, memv_p = [], [], [], [], [], [], [], []
    for l in range(DEPTH):
        lw = (g_pre_mix[l], w_in[l], w_pool[l], s_pool[l], w_gla_gate[l], b_gla_gate[l],
              g_gla_head[l], w_gate[l], b_gate[l], w_b_pool[l], w_b_gla[l], w_b_mem[l], w_o[l],
              g_post_mix[l], g_pre_ffn[l], w_up[l], w_dw[l], b_dw[l], w_down[l], g_post_ffn[l])
        mk, mv = memory_kv(mem_prompt, g_mem[l], w_mem_k[l], w_mem_v[l])
        zp = jnp.zeros((bp, POOL_STATE, POOL_WIDTH), x_prompt.dtype)
        zs = jnp.zeros((bp, GLA_HEADS, GLA_HK, GLA_HV), jnp.float32)
        zc = jnp.zeros((bp, CONV_W - 1, 2 * D_FF), x_prompt.dtype)
        yp, np_, ns_, nc_ = layer(yp, mk, mv, zp, zs, zc, 0, *lw)
        pool_p.append(np_)
        gla_p.append(ns_)
        conv_p.append(nc_)
        memk_p.append(mk)
        memv_p.append(mv)
        ys, np2, ns2, nc2 = layer(ys, cache_mem_k[l], cache_mem_v[l], cache_pool[l], state_gla[l],
                                  cache_ffn_conv[l], PAST_LEN, *lw)
        pool_s.append(np2)
        gla_s.append(ns2)
        conv_s.append(nc2)
    return (yp, ys, jnp.stack(pool_p), jnp.stack(pool_s), jnp.stack(gla_p), jnp.stack(gla_s),
            jnp.stack(conv_p), jnp.stack(conv_s), jnp.stack(memk_p), jnp.stack(memv_p))
```

```cpp
#include <hip/hip_runtime.h>
#include <cstdio>
#include <cstddef>

#define LAS __attribute__((address_space(3)))
#define GAS __attribute__((address_space(1)))
typedef unsigned short bf16_t;
typedef short bf16x8 __attribute__((ext_vector_type(8)));
typedef short s16x4 __attribute__((ext_vector_type(4)));
typedef float f32x4 __attribute__((ext_vector_type(4)));
typedef float f32x2 __attribute__((ext_vector_type(2)));
typedef float f32x16 __attribute__((ext_vector_type(16)));
typedef unsigned u32x4 __attribute__((ext_vector_type(4)));
typedef unsigned u32x2 __attribute__((ext_vector_type(2)));
typedef __bf16 bf16x2_t __attribute__((ext_vector_type(2)));
typedef GAS unsigned gu32;
#define RLX_AGENT __ATOMIC_RELAXED, __HIP_MEMORY_SCOPE_AGENT
#define DI __device__ __forceinline__

DI unsigned pk_bf16(float lo, float hi) { f32x2 v = {lo, hi}; bf16x2_t b = __builtin_convertvector(v, bf16x2_t); return __builtin_bit_cast(unsigned, b); }
DI float bf_lo(unsigned w) { return __uint_as_float(w << 16); }
DI float bf_hi(unsigned w) { return __uint_as_float(w & 0xffff0000u); }
DI float bf2f(bf16_t b) { return __uint_as_float(((unsigned)b) << 16); }
DI u32x4 pack8(f32x4 a, f32x4 b) { u32x4 w; w.x = pk_bf16(a[0], a[1]); w.y = pk_bf16(a[2], a[3]); w.z = pk_bf16(b[0], b[1]); w.w = pk_bf16(b[2], b[3]); return w; }
DI float fsigmoid(float x) { return __builtin_amdgcn_rcpf(1.0f + __expf(-x)); }

constexpr int DM = 2048, NPROMPT = 4 * 4096, NSAMPLE = 32 * 32, MTOK = NPROMPT + NSAMPLE;
constexpr int NMEMROWS = 4 * 256;
constexpr int INW = 4112, FF = 5632, F2 = 11264, FH = 2816;
constexpr float EPS = 1e-6f;
constexpr float MQ_SCALE = 0.08838834764831845f * 1.4426950408889634f;

constexpr int PN_XN = 0, PN_MN = 68, PN_W = 72;
constexpr int WP_U = 0, WP_Q = 2, WP_K = 4, WP_MQ = 6, WP_ALR = 8, WP_G = 9, WP_V = 33, WP_R = 37, WP_MK = 41, WP_MV = 43, WP_END = 45;
constexpr int RB_ROWS = (PN_W + WP_END) * 256;

constexpr size_t MiB = 1u << 20;
constexpr size_t WS_CTL = 0, CTL_ZERO_BYTES = 32768;
constexpr size_t WS_RB = 1 * MiB;
constexpr size_t WS_WUP = 1 * MiB;
constexpr size_t WS_BR = 45 * MiB;
constexpr size_t WS_WDN = 203 * MiB;
constexpr size_t WS_H2 = 67 * MiB;
constexpr size_t WS_WB = 118 * MiB;
constexpr size_t WS_U = 126 * MiB;
constexpr size_t WS_Q = 160 * MiB, WS_K = 177 * MiB, WS_MQ = 194 * MiB;
constexpr size_t WS_ALR = 211 * MiB;
constexpr size_t WS_KM = 213 * MiB, WS_VMT = 214 * MiB, WS_KS = 215 * MiB, WS_VST = 223 * MiB;
constexpr size_t WS_VRT = 231 * MiB;
constexpr size_t WS_G = 299 * MiB;
constexpr size_t WS_WO = 503 * MiB;
constexpr size_t WS_MG = 135 * MiB;
constexpr size_t WS_Y2 = 231 * MiB;
constexpr size_t WS_SSQ = 225 * MiB;
constexpr size_t WS_SCR = 135 * MiB;
constexpr size_t WS_HEAD = 231 * MiB, WS_TAIL = 238 * MiB;
constexpr size_t WS_HG = 322 * MiB;
constexpr size_t WS_F = 135 * MiB;
constexpr size_t WS_SSQ2 = 228 * MiB;
constexpr size_t WS_AGG = 126 * MiB, WS_DCUM = 141 * MiB;
constexpr size_t WS_PART = 299 * MiB;
constexpr size_t WS_PART2 = 246 * MiB;
constexpr size_t WS_END = 512 * MiB;
static_assert(WS_RB + (size_t)RB_ROWS * DM * 2 <= WS_WB, "RB");
static_assert(WS_HG + (size_t)MTOK * FF * 2 <= 511 * MiB, "HG");
static_assert(WS_G + (size_t)MTOK * 6144 * 2 <= WS_WO, "G");
static_assert(WS_VRT + (size_t)2048 * MTOK * 2 <= WS_G, "VRT");

constexpr size_t O_Y = 0, O_POOLP = 35651584, O_POOLS = 35682304, O_GLAP = 35928064, O_GLAS = 36452352, O_CONVP = 40646656, O_CONVS = 40736768, O_MEMK = 41457664, O_MEMV = 41981952, O_TOTAL = 42506240;

constexpr int CW_BAR = 4096;
constexpr int CW_UPDONE = 64;

constexpr int RING_BYTES = 131072, LDSCTL_OFF = RING_BYTES, MISC_OFF = LDSCTL_OFF + 320, LDS_BYTES = 131072 + 1024 + 16384 + 2048;

namespace pg8 {
constexpr int BM = 256, BK = 64, HALF = 128, HTB = HALF * BK * 2, STAGE_BYTES = 8 * HTB;
DI int lds_byte(int r, int c) { const int st = (r >> 4) * 2 + (c >> 5), rr = r & 15, cc = c & 31, ob = rr * 64 + cc * 2; return st * 1024 + (ob ^ (((ob >> 9) & 1) << 5)); }
DI void stage_rc(int b, int& R, int& C) { const int st = b / 1024, sb = b % 1024, swz = sb ^ (((sb >> 9) & 1) << 5); R = (st >> 1) * 16 + swz / 64; C = (st & 1) * 32 + (swz % 64) / 2; }
DI int perm32(int rho) { const int n = rho >> 4, i = rho & 15; return 8 * (i >> 2) + 4 * n + (i & 3); }

struct Unit { int arow, brow, kind, om, on, koff, nt, seq; };
struct Gemm { const bf16_t* A; const bf16_t* B; int lda, ldb, K; };

#ifndef GEMM_WGM
#define GEMM_WGM 4
#endif
DI void grid_map(int wgid, int nM, int nN, int& pm, int& pn, int wgm = 8) {
    const int nwg = nM * nN; { const int q = nwg / 8, r = nwg % 8, xcd = wgid % 8, off = wgid / 8; wgid = (xcd < r ? xcd * (q + 1) : r * (q + 1) + (xcd - r) * q) + off; }
    const int nig = wgm * nN, gid = wgid / nig, fm = gid * wgm, gsz = (nM - fm) < wgm ? (nM - fm) : wgm;
    pm = fm + ((wgid % nig) % gsz); pn = (wgid % nig) / gsz;
    if (nN == 8 && gsz == 8) { pm = fm + (wgid % nig) / 8; pn = (wgid % nig) % 8; }
}
struct Sched2D {
    int nM, nN, G, c, a0, b0, ntK;
    DI bool next(int i, Unit& u) const { const long L = (long)i * G + c; if (L >= (long)nM * nN) return false; int pm, pn; grid_map((int)L, nM, nN, pm, pn);
        u.arow = (a0 + pm) * 256; u.brow = (b0 + pn) * 256; u.kind = 0; u.om = pm; u.on = pn; u.koff = 0; u.nt = ntK; return true; }
};
struct SchedTail {
    int G, c, ntK, np;
    DI bool next(int i, Unit& u) const { const long L = (long)i * G + c; if (L >= 512 + np) return false;
        int pm = 0, pn = 0; grid_map(L < 512 ? (int)L : 0, 64, 8, pm, pn);
        const int x = (int)L - 512, t = x >> 2, kq = x & 3; const bool full = L < 512;
        const int om = full ? pm : 64 + (t >> 3), on = full ? pn : (t & 7);
        Unit r; r.seq = 0; r.arow = om * 256; r.brow = on * 256; r.kind = full ? 0 : 1 + kq; r.om = om; r.on = on; r.koff = full ? 0 : kq * (ntK / 4) * 64; r.nt = full ? ntK : ntK / 4;
        u = r; return true; }
};
struct SchedOne { int pm, pn, ntK;
    DI bool next(int i, Unit& u) const { if (i > 0) return false; Unit r; r.arow = pm * 256; r.brow = pn * 256; r.kind = 0; r.om = pm; r.on = pn; r.koff = 0; r.nt = ntK; r.seq = 0; u = r; return true; } };
struct SchedUp { int G, c;
    DI bool next(int i, Unit& u) const { const long L = (long)i * G + c; if (L >= 68 * 44) return false; int pm, pn;
        if (L < 176) { const int x = (int)L & 7, t = (int)L >> 3; pm = 64 + (x & 3); pn = 2 * t + (x >> 2); }
        else grid_map((int)L - 176, 64, 44, pm, pn, GEMM_WGM);
        Unit r; r.arow = pm * 256; r.brow = pn * 256; r.kind = 0; r.om = pm; r.on = pn; r.koff = 0; r.nt = 32; r.seq = 0; u = r; return true; } };
struct SchedPieces { int G, c;
    DI bool next(int i, Unit& u) const { const int j = (G - 1 - c) + i * G; if (j >= 64) return false; const int t = j >> 1, kq = j & 1;
        Unit r; r.om = 64 + (t >> 3); r.on = t & 7; r.arow = r.om * 256; r.brow = r.on * 256; r.kind = 1 + kq; r.koff = kq * 44 * 64; r.nt = 44; r.seq = 0; u = r; return true; } };
struct SchedP1 {
    int G, c;
    static constexpr int N0 = 68 * 33, N1 = 8 * 68, N2 = 24;
    DI bool next(int i, Unit& u) const { long L = (long)i * G + c; if (L >= N0 + N1 + N2) return false; int pm, pn; u.koff = 0; u.nt = 32;
        if (L < N0) { grid_map((int)L, 68, 33, pm, pn, GEMM_WGM); u.arow = (PN_XN + pm) * 256; u.brow = (PN_W + pn) * 256; u.kind = 0; u.om = pm; u.on = pn; return true; }
        L -= N0;
        if (L < N1) { grid_map((int)L, 8, 68, pm, pn); u.arow = (PN_W + WP_V + pm) * 256; u.brow = (PN_XN + pn) * 256; u.kind = 1; u.om = pm; u.on = pn; return true; }
        L -= N1; const int j = (int)L & 7, t = (int)L >> 3;
        if (t == 0) { u.om = j >> 1; u.on = j & 1; u.arow = (PN_MN + u.om) * 256; u.brow = (PN_W + WP_MK + u.on) * 256; u.kind = 2; }
        else if (t == 1) { u.om = j >> 1; u.on = j & 1; u.arow = (PN_MN + u.om) * 256; u.brow = (PN_W + WP_MV + u.on) * 256; u.kind = 3; }
        else { u.om = j >> 2; u.on = j & 3; u.arow = (PN_W + WP_MV + u.om) * 256; u.brow = (PN_MN + u.on) * 256; u.kind = 4; }
        return true; }
};

DI u32x4 quad16(u32x4 w, int lane) { const int src = (((lane >> 2) + 16 * (lane & 3)) << 2); u32x4 r;
    r.x = (unsigned)__builtin_amdgcn_ds_bpermute(src, (int)w.x); r.y = (unsigned)__builtin_amdgcn_ds_bpermute(src, (int)w.y); r.z = (unsigned)__builtin_amdgcn_ds_bpermute(src, (int)w.z); r.w = (unsigned)__builtin_amdgcn_ds_bpermute(src, (int)w.w); return r; }
typedef f32x4 Acc[2][2][4][2];

struct EpiP1 {
    static constexpr bool HOOK = false;
    unsigned char* ws; float* out; const float* bgate;
    DI void mid(Acc&, const Unit&, int, int, int, int, int) const {}
    DI void operator()(Acc& acc, const Unit& u, int wr, int wc, int fr, int fq) const {
        const int rl = wr * 64 + fr, cl = wc * 32 + 8 * fq;
        float* pf = nullptr; bf16_t* pb = nullptr; unsigned ld = 0; int act = 0; float scale = 1.f; const float* bias = nullptr; bool ok0 = true, ok1 = true;
        const int k = u.kind;
        if (k == 0) {
            const int wp = u.on; const size_t r0 = (size_t)u.om * 256;
            if (wp < WP_Q) { pf = (float*)(ws + WS_U) + r0 * 512 + wp * 256; ld = 512; }
            else if (wp < WP_K) { pb = (bf16_t*)(ws + WS_Q) + r0 * 512 + (wp - WP_Q) * 256; ld = 512; }
            else if (wp < WP_MQ) { pb = (bf16_t*)(ws + WS_K) + r0 * 512 + (wp - WP_K) * 256; ld = 512; }
            else if (wp < WP_ALR) { pb = (bf16_t*)(ws + WS_MQ) + r0 * 512 + (wp - WP_MQ) * 256; ld = 512; scale = MQ_SCALE; }
            else if (wp == WP_ALR) { pf = (float*)(ws + WS_ALR) + r0 * 16; ld = 16; ok0 = (cl < 16); ok1 = false; }
            else { pb = (bf16_t*)(ws + WS_G + (size_t)(u.om * 24 + (wp - WP_G)) * 65536); ld = 256; act = 2; bias = bgate + (wp - WP_G) * 256; }
        } else if (k == 1) { pb = (bf16_t*)(ws + WS_VRT) + (size_t)u.om * 256 * MTOK + u.on * 256; ld = MTOK; act = (u.om >= 4) ? 3 : 0; }
        else if (k == 2) { pf = out + O_MEMK + (size_t)u.om * 256 * 512 + u.on * 256; pb = (bf16_t*)(ws + WS_KM) + (size_t)u.om * 256 * 512 + u.on * 256; ld = 512; }
        else if (k == 3) { pf = out + O_MEMV + (size_t)u.om * 256 * 512 + u.on * 256; ld = 512; }
        else { pb = (bf16_t*)(ws + WS_VMT) + (size_t)u.om * 256 * 1024 + u.on * 256; ld = 1024; }
        const unsigned lo32 = (unsigned)rl * ld + (unsigned)cl;
        const int lane = fr + 16 * fq; const unsigned lq32 = (unsigned)(wr * 64 + (lane >> 2)) * ld + (unsigned)(wc * 32 + 8 * (lane & 3));
#pragma unroll
        for (int bj = 0; bj < 2; ++bj) {
            if (bj == 0 ? !ok0 : !ok1) continue;
            f32x4 b0 = {0.f, 0.f, 0.f, 0.f}, b1 = b0;
            if (act == 2) { b0 = *(const f32x4*)(bias + cl + bj * HALF); b1 = *(const f32x4*)(bias + cl + bj * HALF + 4); }
#pragma unroll
            for (int ai = 0; ai < 2; ++ai)
#pragma unroll
                for (int m = 0; m < 4; ++m) {
                    const size_t uo = (size_t)((ai * HALF + m * 16) * ld + bj * HALF);
                    f32x4 v0 = acc[ai][bj][m][0], v1 = acc[ai][bj][m][1];
                    if (act == 2) {
                        unsigned q[8];
#pragma unroll
                        for (int e = 0; e < 4; ++e) {
                            q[e] = (unsigned)fmaxf(__builtin_amdgcn_rcpf(1.0f + __builtin_amdgcn_exp2f((v0[e] + b0[e]) * -1.4426950408889634f)) * 255.0f + 0.5f, 1.0f);
                            q[4 + e] = (unsigned)fmaxf(__builtin_amdgcn_rcpf(1.0f + __builtin_amdgcn_exp2f((v1[e] + b1[e]) * -1.4426950408889634f)) * 255.0f + 0.5f, 1.0f); }
                        u32x2 w; w.x = q[0] | (q[1] << 8) | (q[2] << 16) | (q[3] << 24); w.y = q[4] | (q[5] << 8) | (q[6] << 16) | (q[7] << 24);
                        *(u32x2*)((unsigned char*)pb + (size_t)(((ai * 4 + m) * 2 + bj) * 8 + wr * 4 + wc) * 512 + lane * 8) = w;
                        continue;
                    } else if (act == 3) {
#pragma unroll
                        for (int e = 0; e < 4; ++e) { v0[e] = v0[e] * fsigmoid(v0[e]); v1[e] = v1[e] * fsigmoid(v1[e]); }
                    } else { v0 = v0 * scale; v1 = v1 * scale; }
                    if (pf) { float* p = pf + uo; *(f32x4*)(p + lo32) = v0; *(f32x4*)(p + lo32 + 4) = v1; }
                    if (pb) { bf16_t* p = pb + uo; *(u32x4*)(p + lq32) = quad16(pack8(v0, v1), lane); }
                }
        }
    }
};

DI float ub8(unsigned w, int k) { return (float)((w >> (8 * k)) & 0xffu); }
struct EpiMerge {
    static constexpr bool HOOK = true;
    unsigned char* ws;
    DI void mid(Acc& acc, const Unit& u, int t, int wr, int wc, int fr, int fq) const {
        if (t != 8 && t != 24) return;
        const unsigned lo8 = (unsigned)(((wr * 4 + wc) * 64 + fr + 16 * fq) * 8);
        const unsigned char* gp = ws + WS_G + (size_t)(u.om * 24 + (t == 8 ? 0 : 8) + u.on) * 65536;
        u32x2 ga[2][4][2], gb[2][4][2];
#pragma unroll
        for (int ai = 0; ai < 2; ++ai)
#pragma unroll
            for (int m = 0; m < 4; ++m)
#pragma unroll
                for (int bj = 0; bj < 2; ++bj) { const unsigned char* p = gp + (size_t)(((ai * 4 + m) * 2 + bj) * 4096); ga[ai][m][bj] = *(const u32x2*)(p + lo8); gb[ai][m][bj] = *(const u32x2*)(p + 8 * 65536 + lo8); }
#pragma unroll
        for (int ai = 0; ai < 2; ++ai)
#pragma unroll
            for (int m = 0; m < 4; ++m)
#pragma unroll
                for (int bj = 0; bj < 2; ++bj) { const u32x2 a = ga[ai][m][bj], b = gb[ai][m][bj];
                    f32x4 r0, r1;
#pragma unroll
                    for (int e = 0; e < 4; ++e) { r0[e] = ub8(a.x, e) * __builtin_amdgcn_rcpf(ub8(b.x, e)); r1[e] = ub8(a.y, e) * __builtin_amdgcn_rcpf(ub8(b.y, e)); }
                    acc[ai][bj][m][0] *= r0; acc[ai][bj][m][1] *= r1; }
        asm volatile("" ::: "memory");
    }
    DI void operator()(Acc& acc, const Unit& u, int wr, int wc, int fr, int fq) const {
        const int lane = fr + 16 * fq;
        const unsigned lg8 = (unsigned)(((wr * 4 + wc) * 64 + lane) * 8), lo32 = (unsigned)(wr * 64 + (lane >> 2)) * (unsigned)DM + (unsigned)(wc * 32 + 8 * (lane & 3));
        const unsigned char* gp = ws + WS_G + (size_t)(u.om * 24 + 16 + u.on) * 65536;
        bf16_t* op = (bf16_t*)(ws + WS_MG) + (size_t)u.om * 256 * DM + u.on * 256;
#pragma unroll
        for (int ai = 0; ai < 2; ++ai) {
            u32x2 ga[4][2];
#pragma unroll
            for (int m = 0; m < 4; ++m)
#pragma unroll
                for (int bj = 0; bj < 2; ++bj) ga[m][bj] = *(const u32x2*)(gp + (size_t)(((ai * 4 + m) * 2 + bj) * 4096) + lg8);
#pragma unroll
            for (int m = 0; m < 4; ++m)
#pragma unroll
                for (int bj = 0; bj < 2; ++bj) { const u32x2 a = ga[m][bj];
                    f32x4 v0 = acc[ai][bj][m][0], v1 = acc[ai][bj][m][1];
#pragma unroll
                    for (int e = 0; e < 4; ++e) { v0[e] *= ub8(a.x, e) * (1.0f / 255.0f); v1[e] *= ub8(a.y, e) * (1.0f / 255.0f); }
                    *(u32x4*)(op + (size_t)((ai * HALF + m * 16) * DM + bj * HALF) + lo32) = quad16(pack8(v0, v1), lane); }
            asm volatile("" ::: "memory");
        }
    }
};

struct EpiNorm {
    static constexpr bool HOOK = false;
    bf16_t* Y; float* SSQ; float* PART;
    DI void mid(Acc&, const Unit&, int, int, int, int, int) const {}
    DI void operator()(Acc& acc, const Unit& u, int wr, int wc, int fr, int fq) const {
        if (u.kind != 0) {
            float* pp = PART + ((size_t)(u.kind - 1) * 1024 + (size_t)(u.om - 64) * 256) * DM + u.on * 256;
            const unsigned lp32 = (unsigned)(wr * 64 + fr) * (unsigned)DM + (unsigned)(wc * 32 + 8 * fq);
#pragma unroll
            for (int ai = 0; ai < 2; ++ai)
#pragma unroll
                for (int m = 0; m < 4; ++m)
#pragma unroll
                    for (int bj = 0; bj < 2; ++bj) { float* p = pp + (size_t)((ai * HALF + m * 16) * DM + bj * HALF); *(f32x4*)(p + lp32) = acc[ai][bj][m][0]; *(f32x4*)(p + lp32 + 4) = acc[ai][bj][m][1]; }
            return;
        }
        const int lane = fr + 16 * fq;
        const unsigned lo32 = (unsigned)(wr * 64 + (lane >> 2)) * (unsigned)DM + (unsigned)(wc * 32 + 8 * (lane & 3)), ls32 = (unsigned)(wr * 64 + fr) * 32u;
        bf16_t* op = Y + (size_t)u.om * 256 * DM + u.on * 256; float* sp = SSQ + (size_t)u.om * 256 * 32 + u.on * 4 + wc;
#pragma unroll
        for (int ai = 0; ai < 2; ++ai)
#pragma unroll
            for (int m = 0; m < 4; ++m) {
                float s = 0.f;
#pragma unroll
                for (int bj = 0; bj < 2; ++bj) {
                    const f32x4 v0 = acc[ai][bj][m][0], v1 = acc[ai][bj][m][1];
                    s += (v0[0] * v0[0] + v0[1] * v0[1]) + (v0[2] * v0[2] + v0[3] * v0[3]) + (v1[0] * v1[0] + v1[1] * v1[1]) + (v1[2] * v1[2] + v1[3] * v1[3]);
                    *(u32x4*)(op + (size_t)((ai * HALF + m * 16) * DM + bj * HALF) + lo32) = quad16(pack8(v0, v1), lane);
                }
                s += __shfl_xor(s, 16); s += __shfl_xor(s, 32);
                if (fq == 0) sp[(size_t)((ai * HALF + m * 16) * 32) + ls32] = s;
            }
    }
};

DI float gelu_tanh_f(float x) { const float z = 1.5957691216057308f * (x + 0.044715f * x * x * x); return x * __builtin_amdgcn_rcpf(1.0f + __expf(-z)); }
DI void unpack8(u32x4 w, float (&v)[8]) { v[0] = bf_lo(w.x); v[1] = bf_hi(w.x); v[2] = bf_lo(w.y); v[3] = bf_hi(w.y); v[4] = bf_lo(w.z); v[5] = bf_hi(w.z); v[6] = bf_lo(w.w); v[7] = bf_hi(w.w); }
DI void unpack4(u32x2 w, float (&v)[4]) { v[0] = bf_lo(w.x); v[1] = bf_hi(w.x); v[2] = bf_lo(w.y); v[3] = bf_hi(w.y); }
constexpr int UPC_A = 3 * 16384, UPC_B = 131072 + 1024, UPC_CARRY = UPC_B + 16384;
struct EpiUpConv {
    static constexpr bool HOOK = false;
    unsigned char* ws; float* out; const float* wdw; const float* bdw; const float* hist; LAS unsigned char* lds;
    DI void mid(Acc&, const Unit&, int, int, int, int, int) const {}
    DI void operator()(Acc& acc, const Unit& u, int wr, int wc, int fr, int fq) const {
        const bool sample = u.om >= 64, contin = !sample && (u.om & 15) != 0;
        int tid = threadIdx.x; asm volatile("" : "+v"(tid));
        fr = tid & 15; fq = (tid >> 4) & 3;
        const int fgp = tid & 31, rg = tid >> 5, feat = u.on * 128 + fgp * 4;
        f32x4 wg[3], wv[3], bg, bv;
#pragma unroll
        for (int i = 0; i < 3; ++i) { wg[i] = *(const f32x4*)(wdw + (size_t)i * F2 + feat); wv[i] = *(const f32x4*)(wdw + (size_t)i * F2 + FF + feat); }
        bg = *(const f32x4*)(bdw + feat); bv = *(const f32x4*)(bdw + FF + feat);
        u32x4 pk[2][4][2];
        {
            const int rl = wr * 64 + fr, cl = wc * 32 + 8 * fq;
#pragma unroll
            for (int ai = 0; ai < 2; ++ai)
#pragma unroll
                for (int m = 0; m < 4; ++m) {
                    const int row = rl + ai * HALF + m * 16, gm = u.om * 256 + row; float* cp = nullptr;
                    if (!sample) { const int t = gm & 4095; if (t >= 4094) cp = out + O_CONVP + ((size_t)(gm >> 12) * 2 + (t - 4094)) * F2; }
                    else { const int t = (gm - NPROMPT) & 31; if (t >= 30) cp = out + O_CONVS + ((size_t)((gm - NPROMPT) >> 5) * 2 + (t - 30)) * F2; }
                    if (cp) {
#pragma unroll
                        for (int bj = 0; bj < 2; ++bj) { float* q = cp + bj * FF + u.on * 128 + cl; *(f32x4*)q = acc[ai][bj][m][0]; *(f32x4*)(q + 4) = acc[ai][bj][m][1]; } }
#pragma unroll
                    for (int bj = 0; bj < 2; ++bj) pk[ai][m][bj] = pack8(acc[ai][bj][m][0], acc[ai][bj][m][1]);
                }
        }
        LAS unsigned char* chA = lds + UPC_A; LAS unsigned char* chB = lds + UPC_B; LAS unsigned char* carry = lds + UPC_CARRY;
#pragma unroll
        for (int c = 0; c < 4; ++c) {
            if (wr == (c & 1)) {
#pragma unroll
                for (int m = 0; m < 4; ++m)
#pragma unroll
                    for (int bj = 0; bj < 2; ++bj) { const int row = m * 16 + fr, gran = bj * 16 + wc * 4 + fq;
                        *(LAS u32x4*)(((row & 32) ? chB : chA) + (row & 31) * 512 + ((gran ^ (row & 31)) << 4)) = pk[c >> 1][m][bj]; }
            }
            asm volatile("s_waitcnt lgkmcnt(0)" ::: "memory"); __builtin_amdgcn_s_barrier(); asm volatile("" ::: "memory");
            u32x2 gr[6], vr[6];
#pragma unroll
            for (int i = 0; i < 6; ++i) {
                const int r = 4 * rg - 2 + i;
                if (i >= 2 || rg > 0) { const LAS unsigned char* p = ((r & 32) ? chB : chA) + (r & 31) * 512; const int sw = r & 31;
                    gr[i] = *(const LAS u32x2*)(p + (((fgp >> 1) ^ sw) << 4) + (fgp & 1) * 8); vr[i] = *(const LAS u32x2*)(p + (((16 + (fgp >> 1)) ^ sw) << 4) + (fgp & 1) * 8); }
                else if (c > 0) { const LAS unsigned char* q = carry + ((c - 1) & 1) * 1024 + i * 512; gr[i] = *(const LAS u32x2*)(q + fgp * 8); vr[i] = *(const LAS u32x2*)(q + 256 + fgp * 8); }
                else { gr[i] = (u32x2){0u, 0u}; vr[i] = gr[i]; }
            }
            f32x2 G[6][2], V[6][2];
#pragma unroll
            for (int i = 0; i < 6; ++i) { float t4[4]; unpack4(gr[i], t4); G[i][0] = (f32x2){t4[0], t4[1]}; G[i][1] = (f32x2){t4[2], t4[3]}; unpack4(vr[i], t4); V[i][0] = (f32x2){t4[0], t4[1]}; V[i][1] = (f32x2){t4[2], t4[3]}; }
            if (sample && (rg & 7) == 0) {
                const int b = ((u.om - 64) * 256 + c * 64 + 4 * rg) >> 5; const float* hp = hist + (size_t)b * 2 * F2 + feat;
                const f32x4 a0 = *(const f32x4*)hp, a1 = *(const f32x4*)(hp + F2), c0 = *(const f32x4*)(hp + FF), c1 = *(const f32x4*)(hp + F2 + FF);
                G[0][0] = (f32x2){a0[0], a0[1]}; G[0][1] = (f32x2){a0[2], a0[3]}; G[1][0] = (f32x2){a1[0], a1[1]}; G[1][1] = (f32x2){a1[2], a1[3]};
                V[0][0] = (f32x2){c0[0], c0[1]}; V[0][1] = (f32x2){c0[2], c0[3]}; V[1][0] = (f32x2){c1[0], c1[1]}; V[1][1] = (f32x2){c1[2], c1[3]};
            }
            if (!sample && ((c == 0 && rg == 0) || (c == 3 && rg == 15))) {
                float* hp = (float*)(ws + (c == 0 ? WS_HEAD : WS_TAIL)) + (size_t)u.om * 2 * F2 + feat;
#pragma unroll
                for (int rr = 0; rr < 2; ++rr) { const int ri = (c == 0 ? 2 : 4) + rr;
                    *(f32x4*)(hp + (size_t)rr * F2) = (f32x4){G[ri][0].x, G[ri][0].y, G[ri][1].x, G[ri][1].y}; *(f32x4*)(hp + (size_t)rr * F2 + FF) = (f32x4){V[ri][0].x, V[ri][0].y, V[ri][1].x, V[ri][1].y}; }
            }
            bf16_t* op = (bf16_t*)(ws + WS_HG) + ((size_t)u.om * 256 + c * 64 + 4 * rg) * FF + feat;
            const f32x2 K1 = {-2.3022082f, -2.3022082f}, K3 = {-0.10294324f, -0.10294324f}, ONE = {1.0f, 1.0f};
            f32x2 CG[4][2], CV[4][2], UU[4][2];
#pragma unroll
            for (int p = 0; p < 2; ++p) {
                const f32x2 w0 = {wg[0][2 * p], wg[0][2 * p + 1]}, w1 = {wg[1][2 * p], wg[1][2 * p + 1]}, w2 = {wg[2][2 * p], wg[2][2 * p + 1]}, wb = {bg[2 * p], bg[2 * p + 1]};
                const f32x2 x0 = {wv[0][2 * p], wv[0][2 * p + 1]}, x1 = {wv[1][2 * p], wv[1][2 * p + 1]}, x2 = {wv[2][2 * p], wv[2][2 * p + 1]}, xb = {bv[2 * p], bv[2 * p + 1]};
#pragma unroll
                for (int i = 0; i < 4; ++i) { CG[i][p] = w0 * G[i][p] + (w1 * G[i + 1][p] + (w2 * G[i + 2][p] + wb)); CV[i][p] = x0 * V[i][p] + (x1 * V[i + 1][p] + (x2 * V[i + 2][p] + xb)); }
            }
#pragma unroll
            for (int i = 0; i < 4; ++i)
#pragma unroll
                for (int p = 0; p < 2; ++p) UU[i][p] = CG[i][p] * (CG[i][p] * CG[i][p] * K3 + K1);
#pragma unroll
            for (int i = 0; i < 4; ++i)
#pragma unroll
                for (int p = 0; p < 2; ++p) UU[i][p] = (f32x2){__builtin_amdgcn_exp2f(UU[i][p].x), __builtin_amdgcn_exp2f(UU[i][p].y)} + ONE;
#pragma unroll
            for (int i = 0; i < 4; ++i)
#pragma unroll
                for (int p = 0; p < 2; ++p) UU[i][p] = (f32x2){__builtin_amdgcn_rcpf(UU[i][p].x), __builtin_amdgcn_rcpf(UU[i][p].y)};
#pragma unroll
            for (int i = 0; i < 4; ++i) {
                const f32x2 h0 = CG[i][0] * UU[i][0] * CV[i][0], h1 = CG[i][1] * UU[i][1] * CV[i][1];
                if (!(contin && c == 0 && rg == 0 && i < 2)) { u32x2 w; w.x = pk_bf16(h0.x, h0.y); w.y = pk_bf16(h1.x, h1.y); *(u32x2*)(op + (size_t)i * FF) = w; }
            }
            if (c < 3 && rg == 15) { LAS unsigned char* q = carry + (c & 1) * 1024 + fgp * 8;
                *(LAS u32x2*)q = gr[4]; *(LAS u32x2*)(q + 256) = vr[4]; *(LAS u32x2*)(q + 512) = gr[5]; *(LAS u32x2*)(q + 768) = vr[5]; }
            asm volatile("s_waitcnt lgkmcnt(0)" ::: "memory"); __builtin_amdgcn_s_barrier(); asm volatile("" ::: "memory");
        }
        if (sample) {
            asm volatile("s_waitcnt vmcnt(0)" ::: "memory"); __builtin_amdgcn_s_barrier(); asm volatile("" ::: "memory");
            if (threadIdx.x == 0) { __builtin_amdgcn_fence(__ATOMIC_RELEASE, "agent"); (void)__hip_atomic_fetch_add((unsigned*)(ws + WS_CTL) + CW_UPDONE + (u.om - 64) * 32, 1u, __ATOMIC_RELAXED, __HIP_MEMORY_SCOPE_AGENT); }
        }
    }
};

template <class Epi, class Sched>
DI void gemm_phase(LAS unsigned char* lds, const Gemm g, const Sched& S, const Epi& E) {
    const int tid = threadIdx.x, wid = __builtin_amdgcn_readfirstlane(tid >> 6), lane = tid & 63, wr = wid >> 2, wc = wid & 3, fr = lane & 15, fq = lane >> 4;
    unsigned voffA[2], voffB[2];
#pragma unroll
    for (int i = 0; i < 2; ++i) { int R, C; stage_rc(tid * 16 + i * 8192, R, C); const int Rb = (R & ~31) + perm32(R & 31);
        voffA[i] = (unsigned)(R * g.lda + C) * 2u; voffB[i] = (unsigned)(Rb * g.ldb + C) * 2u; }
    const size_t kstep = (size_t)(BK * 2);
    const size_t hstepA = (size_t)HALF * g.lda * 2, hstepB = (size_t)HALF * g.ldb * 2;
    const size_t rstepA = (size_t)g.lda * 2, rstepB = (size_t)g.ldb * 2;
    const unsigned ldsw = (unsigned)wid * 1024u;
    const int aoff = lds_byte(wr * 64 + fr, fq * 8), boff = lds_byte(wc * 32 + fr, fq * 8);
#define PG8_SA(b, h) (((b) * 2 + (h)) * HTB)
#define PG8_SB(b, h) ((4 + (b) * 2 + (h)) * HTB)
#define PG8_STAGE(bufoff, gbase, voff) do { _Pragma("unroll") for (int _i = 0; _i < 2; ++_i) \
        __builtin_amdgcn_global_load_lds((const unsigned*)((const char*)(gbase) + (voff)[_i]), (LAS unsigned*)(lds + (bufoff) + ldsw + _i * 8192), 16, 0, 0); } while (0)
#define PG8_LDA(dst, b, h) do { _Pragma("unroll") for (int m = 0; m < 4; ++m) _Pragma("unroll") for (int k = 0; k < 2; ++k) dst[m][k] = *(const LAS bf16x8*)(lds + PG8_SA(b, h) + aoff + m * 2048 + k * 1024); } while (0)
#define PG8_LDB(dst, b, h) do { _Pragma("unroll") for (int n = 0; n < 2; ++n) _Pragma("unroll") for (int k = 0; k < 2; ++k) dst[n][k] = *(const LAS bf16x8*)(lds + PG8_SB(b, h) + boff + n * 2048 + k * 1024); } while (0)
#define PG8_MMA(ai, bj, At, Bt) do { __builtin_amdgcn_s_setprio(1); _Pragma("unroll") for (int m = 0; m < 4; ++m) _Pragma("unroll") for (int n = 0; n < 2; ++n) _Pragma("unroll") for (int k = 0; k < 2; ++k) \
        acc[ai][bj][m][n] = __builtin_amdgcn_mfma_f32_16x16x32_bf16(Bt[n][k], At[m][k], acc[ai][bj][m][n], 0, 0, 0); __builtin_amdgcn_s_setprio(0); } while (0)
#define PG8_WAIT_V(n) asm volatile("s_waitcnt vmcnt(" #n ")" ::: "memory")
#define PG8_WAIT_L(n) asm volatile("s_waitcnt lgkmcnt(" #n ")" ::: "memory")
#define PG8_BAR __builtin_amdgcn_s_barrier()
#define PG8_SCHED __builtin_amdgcn_sched_barrier(0)
    Unit cur, nxt; int ui = 0;
    if (!S.next(0, cur)) return;
    Acc acc;
#pragma unroll
    for (int a = 0; a < 2; ++a)
#pragma unroll
        for (int b = 0; b < 2; ++b)
#pragma unroll
            for (int m = 0; m < 4; ++m)
#pragma unroll
                for (int n = 0; n < 2; ++n) acc[a][b][m][n] = (f32x4){0.f, 0.f, 0.f, 0.f};
    bf16x8 At[4][2], B0[2][2], B1[2][2];
    const char* cA = (const char*)g.A + (size_t)cur.arow * rstepA + (size_t)cur.koff * 2; const char* cB = (const char*)g.B + (size_t)cur.brow * rstepB + (size_t)cur.koff * 2;
    PG8_STAGE(PG8_SB(0, 0), cB, voffB); PG8_STAGE(PG8_SB(0, 1), cB + hstepB, voffB); PG8_STAGE(PG8_SA(0, 0), cA, voffA); PG8_STAGE(PG8_SA(0, 1), cA + hstepA, voffA);
    if (wr == 1) PG8_BAR;
    PG8_WAIT_V(2); PG8_BAR;
    PG8_STAGE(PG8_SB(1, 0), cB + kstep, voffB); PG8_STAGE(PG8_SA(1, 0), cA + kstep, voffA); PG8_STAGE(PG8_SB(1, 1), cB + hstepB + kstep, voffB);
    PG8_WAIT_V(6); PG8_BAR;
    for (;;) {
        const bool has_next = S.next(ui + 1, nxt);
        const char* nA = has_next ? (const char*)g.A + (size_t)nxt.arow * rstepA + (size_t)nxt.koff * 2 : cA; const char* nB = has_next ? (const char*)g.B + (size_t)nxt.brow * rstepB + (size_t)nxt.koff * 2 : cB;
        const int nt = cur.nt;
        for (int t = 0; t < nt; t += 2) {
            const bool last = (t == nt - 2);
            const char* a1 = cA + (size_t)(t + 1) * kstep;
            const char* a2 = last ? nA : cA + (size_t)(t + 2) * kstep; const char* b2 = last ? nB : cB + (size_t)(t + 2) * kstep;
            const char* a3 = a2 + kstep; const char* b3 = b2 + kstep;
            if constexpr (Epi::HOOK) E.mid(acc, cur, t, wr, wc, fr, fq);
            PG8_LDB(B0, 0, 0); PG8_LDB(B1, 0, 1); PG8_SCHED; PG8_LDA(At, 0, 0); PG8_STAGE(PG8_SA(1, 1), a1 + hstepA, voffA);
            PG8_WAIT_V(8); PG8_WAIT_L(0); PG8_BAR; PG8_MMA(0, 0, At, B0); PG8_MMA(0, 1, At, B1); PG8_BAR; PG8_SCHED;
            PG8_LDA(At, 0, 1); PG8_STAGE(PG8_SB(0, 0), b2, voffB); PG8_STAGE(PG8_SB(0, 1), b2 + hstepB, voffB); PG8_STAGE(PG8_SA(0, 0), a2, voffA);
            PG8_WAIT_V(8); PG8_WAIT_L(0); PG8_BAR; PG8_MMA(1, 0, At, B0); PG8_MMA(1, 1, At, B1); PG8_BAR; PG8_SCHED;
            PG8_LDB(B0, 1, 0); PG8_LDB(B1, 1, 1); PG8_SCHED; PG8_LDA(At, 1, 0); PG8_STAGE(PG8_SA(0, 1), a2 + hstepA, voffA);
            PG8_WAIT_V(8); PG8_WAIT_L(0); PG8_BAR; PG8_MMA(0, 0, At, B0); PG8_MMA(0, 1, At, B1); PG8_BAR; PG8_SCHED;
            PG8_LDA(At, 1, 1); PG8_STAGE(PG8_SB(1, 0), b3, voffB); PG8_STAGE(PG8_SB(1, 1), b3 + hstepB, voffB); PG8_STAGE(PG8_SA(1, 0), a3, voffA);
            PG8_WAIT_V(8); PG8_WAIT_L(0); PG8_BAR; PG8_MMA(1, 0, At, B0); PG8_MMA(1, 1, At, B1); PG8_BAR; PG8_SCHED;
        }
        if (wr == 0) PG8_BAR;
        cur.seq = ui; E(acc, cur, wr, wc, fr, fq);
        if (!has_next) break;
#pragma unroll
        for (int a = 0; a < 2; ++a)
#pragma unroll
            for (int b = 0; b < 2; ++b)
#pragma unroll
                for (int m = 0; m < 4; ++m)
#pragma unroll
                    for (int n = 0; n < 2; ++n) acc[a][b][m][n] = (f32x4){0.f, 0.f, 0.f, 0.f};
        cur = nxt; cA = nA; cB = nB; ++ui;
        if (wr == 1) PG8_BAR;
    }
    PG8_WAIT_V(0);
    PG8_BAR;
#undef PG8_SA
#undef PG8_SB
#undef PG8_STAGE
#undef PG8_LDA
#undef PG8_LDB
#undef PG8_MMA
#undef PG8_WAIT_V
#undef PG8_WAIT_L
#undef PG8_BAR
#undef PG8_SCHED
}
}

#define XB_TMO      128
#define XB_XCNT(j)  (256  + 64 * (j))
#define XB_XSUB(j)  (1280 + 64 * (j))
#define XB_XGEN(j)  (2304 + 64 * (j))
#define XB_TOP      3328
#define XB_TOPGEN   3392
#define XCD_BAR_WORDS 3456
#define XB_SPIN_CAP (1u << 18)
DI unsigned xb_ld(unsigned* p)              { return __hip_atomic_load(p, __ATOMIC_RELAXED, __HIP_MEMORY_SCOPE_AGENT); }
DI unsigned xb_add(unsigned* p, unsigned v) { return __hip_atomic_fetch_add(p, v, __ATOMIC_RELAXED, __HIP_MEMORY_SCOPE_AGENT); }
DI unsigned xb_xcc_id() { return (unsigned)__builtin_amdgcn_s_getreg((3 << 11) | 20) & 0xFu; }
#define XB_SPIN(cond, bar) do { unsigned _sp = 0; while (cond) { __builtin_amdgcn_s_sleep(1); \
    if ((++_sp & 255u) == 0u) { if (xb_ld(&(bar)[XB_TMO])) break; if (_sp > XB_SPIN_CAP) { atomicAdd(&(bar)[XB_TMO], 1u); break; } } } } while (0)
struct XcdBarrier { unsigned* bar; unsigned x; volatile LAS unsigned* st; };
DI XcdBarrier xcd_barrier_post(unsigned* bar, volatile LAS unsigned* st) {
    XcdBarrier b; b.bar = bar; b.x = xb_xcc_id(); b.st = st;
    if (threadIdx.x == 0) (void)xb_add(&bar[XB_XCNT(b.x)], 1u);
    return b;
}
DI void xcd_barrier_complete(unsigned* bar, unsigned x, unsigned& nloc, unsigned& nx) {
    const unsigned G = gridDim.x * gridDim.y * gridDim.z;
    unsigned sum, cnt, mine, sp = 0u;
    for (;;) {
        sum = 0u; cnt = 0u; mine = 0u;
#pragma unroll
        for (unsigned j = 0; j < 16; ++j) { const unsigned c = xb_ld(&bar[XB_XCNT(j)]); sum += c; cnt += (c > 0u) ? 1u : 0u; mine = (j == x) ? c : mine; }
        if (sum == G) break;
        __builtin_amdgcn_s_sleep(1);
        if ((++sp & 255u) == 0u) { if (xb_ld(&bar[XB_TMO])) break; if (sp > XB_SPIN_CAP) { atomicAdd(&bar[XB_TMO], 1u); break; } }
    }
    nloc = mine > 0u ? mine : 1u; nx = cnt > 0u ? cnt : 1u;
}
DI void xcd_barrier(const XcdBarrier& b) {
    asm volatile("s_waitcnt vmcnt(0)" ::: "memory");
    __syncthreads();
    if (threadIdx.x == 0) {
        unsigned* bar = b.bar;
        __builtin_amdgcn_s_waitcnt(0);
        unsigned nloc = b.st[0], nx = b.st[1];
        if (nloc == 0u) { xcd_barrier_complete(bar, b.x, nloc, nx); b.st[0] = nloc; b.st[1] = nx; }
        const unsigned old = xb_add(&bar[XB_XSUB(b.x)], 1u);
        const unsigned gen = old / nloc;
        if (old + 1u == (gen + 1u) * nloc) {
            __builtin_amdgcn_fence(__ATOMIC_RELEASE, "agent");
            asm volatile("s_waitcnt vmcnt(0)" ::: "memory");
            const unsigned og = xb_add(&bar[XB_TOP], 1u);
            const unsigned tg = og / nx;
            if (og + 1u == (tg + 1u) * nx) xb_add(&bar[XB_TOPGEN], 1u);
            else XB_SPIN(xb_ld(&bar[XB_TOPGEN]) == tg, bar);
            __builtin_amdgcn_fence(__ATOMIC_ACQUIRE, "agent");
            xb_add(&bar[XB_XGEN(b.x)], 1u);
            asm volatile("s_waitcnt vmcnt(0)" ::: "memory");
        } else {
            XB_SPIN(xb_ld(&bar[XB_XGEN(b.x)]) == gen, bar);
            __builtin_amdgcn_fence(__ATOMIC_ACQUIRE, "agent");
            asm volatile("s_waitcnt vmcnt(0)" ::: "memory");
        }
    }
    __syncthreads();
}

#define LDS_WAIT() asm volatile("s_waitcnt lgkmcnt(0)" ::: "memory")
DI float wave_sum(float v) {
#pragma unroll
    for (int o = 1; o < 64; o <<= 1) v += __shfl_xor(v, o);
    return v;
}
DI void tr_item(const float* W, size_t ldw, int col, int k0, bf16_t* dst, size_t dld, LAS float* scr, int lane) {
    float tv[32];
    { const float* wp0 = W + (size_t)(k0 + (lane >> 5)) * ldw + col + (lane & 31);
#pragma unroll
      for (int i = 0; i < 32; ++i) tv[i] = wp0[(size_t)(2 * i) * ldw]; }
#pragma unroll
    for (int i = 0; i < 32; ++i) { const int kk = 2 * i + (lane >> 5); scr[kk * 33 + (lane & 31)] = tv[i]; }
    LDS_WAIT(); asm volatile("" ::: "memory");
    const int c = lane & 7;
#pragma unroll
    for (int j = 0; j < 4; ++j) { const int n = (lane >> 3) + 8 * j; const LAS float* s = scr + (8 * c) * 33 + n;
        u32x4 o; o.x = pk_bf16(s[0 * 33], s[1 * 33]); o.y = pk_bf16(s[2 * 33], s[3 * 33]); o.z = pk_bf16(s[4 * 33], s[5 * 33]); o.w = pk_bf16(s[6 * 33], s[7 * 33]);
        *(u32x4*)(dst + (size_t)n * dld + 8 * c) = o; }
    LDS_WAIT(); asm volatile("" ::: "memory");
}
struct TrSrc { const float* src; bf16_t* dst; unsigned ldw, dld; };
DI void tr_load(float (&tv)[32], const TrSrc& t, int lane) {
    const float* wp0 = t.src + (size_t)(lane >> 5) * t.ldw + (lane & 31);
#pragma unroll
    for (int i = 0; i < 32; ++i) tv[i] = wp0[(size_t)(2 * i) * t.ldw];
}
DI void tr_store(const float (&tv)[32], const TrSrc& t, LAS float* scr, int lane) {
#pragma unroll
    for (int i = 0; i < 32; ++i) { const int kk = 2 * i + (lane >> 5); scr[kk * 33 + (lane & 31)] = tv[i]; }
    LDS_WAIT(); asm volatile("" ::: "memory");
    const int c = lane & 7;
#pragma unroll
    for (int j = 0; j < 4; ++j) { const int n = (lane >> 3) + 8 * j; const LAS float* s = scr + (8 * c) * 33 + n;
        u32x4 o; o.x = pk_bf16(s[0 * 33], s[1 * 33]); o.y = pk_bf16(s[2 * 33], s[3 * 33]); o.z = pk_bf16(s[4 * 33], s[5 * 33]); o.w = pk_bf16(s[6 * 33], s[7 * 33]);
        *(u32x4*)(t.dst + (size_t)n * t.dld + 8 * c) = o; }
    LDS_WAIT(); asm volatile("" ::: "memory");
}
template <class DEC> DI void tr_pipeline(DEC dec, int i0, int i1, int g, int NG, LAS float* scr, int lane) {
    int it = i0 + g;
    if (it >= i1) return;
    float A[32], B[32];
    TrSrc ta = dec(it), tb;
    tr_load(A, ta, lane);
    while (true) {
        int nx = it + NG; bool more = nx < i1;
        tb = dec(more ? nx : it); tr_load(B, tb, lane);
        tr_store(A, ta, scr, lane);
        if (!more) break;
        it = nx; nx = it + NG; more = nx < i1;
        ta = dec(more ? nx : it); tr_load(A, ta, lane);
        tr_store(B, tb, scr, lane);
        if (!more) break;
        it = nx;
    }
}
DI void rms_row_to_bf16(const float* xrow, const float* gain, bf16_t* orow, int lane) {
    const f32x4* xr = (const f32x4*)xrow + lane; const f32x4* gr = (const f32x4*)gain + lane;
    f32x4 v[8]; float s = 0.f;
#pragma unroll
    for (int j = 0; j < 8; ++j) { v[j] = xr[64 * j]; s += (v[j].x * v[j].x + v[j].y * v[j].y) + (v[j].z * v[j].z + v[j].w * v[j].w); }
    const float rstd = 1.0f / sqrtf(wave_sum(s) * (1.f / DM) + EPS);
    u32x2* o8 = (u32x2*)orow + lane;
#pragma unroll
    for (int j = 0; j < 8; ++j) { const f32x4 gg = gr[64 * j]; u32x2 w; w.x = pk_bf16(v[j].x * rstd * gg.x, v[j].y * rstd * gg.y); w.y = pk_bf16(v[j].z * rstd * gg.z, v[j].w * rstd * gg.w); o8[64 * j] = w; }
}

struct Args { const float* in[31]; float* out; unsigned char* ws; int ph_lo, ph_hi, li, pad; };
constexpr int ARGS_DW = sizeof(Args) / 4;
constexpr int LDSARGS_OFF = MISC_OFF + 128;
#ifndef GMASK
#define GMASK 866
#endif
template <class T> DI T* as_global(T* p) { return (T*)(__attribute__((address_space(1))) T*)(unsigned long long)p; }
template <bool GL = false> DI Args fetch_args(LAS unsigned char* lds) {
    Args a; unsigned* w = (unsigned*)&a; const LAS unsigned* la = (const LAS unsigned*)(lds + LDSARGS_OFF);
#pragma unroll
    for (int i = 0; i < ARGS_DW; ++i) w[i] = (unsigned)__builtin_amdgcn_readfirstlane((int)la[i]);
    if (GL) {
#pragma unroll
        for (int i = 0; i < 31; ++i) a.in[i] = as_global(a.in[i]);
        a.out = as_global(a.out); a.ws = as_global(a.ws); }
    return a;
}

DI void p0_prologue(const Args& a, LAS unsigned char* lds, int gw, int NGW, int wave, int lane) {
    LAS float* scr = (LAS float*)(lds + wave * 16384);
    unsigned char* ws = a.ws;
    bf16_t* RB = (bf16_t*)(ws + WS_RB); bf16_t* WBt = (bf16_t*)(ws + WS_WB);
    const float* w_in = a.in[12]; const float* w_gate = a.in[18];
    constexpr int J_U = 512, J_Q = 512, J_K = 512, J_V = 1024, J_R = 1024, J_MQ = 512, J_G = 6144, J_MK = 512, J_MV = 512, J_BG = 1024, J_BM = 512, J_VS = 2048, J_WC = 2048;
    constexpr int NTR = J_U + J_Q + J_K + J_V + J_R + J_MQ + J_G + J_MK + J_MV + J_BG + J_BM + J_VS + J_WC;
    constexpr int NROW = MTOK + NMEMROWS, NKS = 2048, NPAD = 240;
    constexpr int NITEMS = NTR + NROW + NKS + NPAD;
    constexpr int NTRP = J_U + J_Q + J_K + J_V + J_R + J_MQ + J_G + J_MK + J_MV + J_BG + J_BM + J_VS;
    {
        const float* gw_in = as_global(w_in); const float* gw_gate = as_global(w_gate); const float* gmk = as_global(a.in[9]); const float* gmv = as_global(a.in[10]);
        const float* gbg = as_global(a.in[21]); const float* gbm = as_global(a.in[22]); const float* gvs = as_global(a.in[7]); unsigned char* gws = as_global(ws);
        tr_pipeline([=](int r) -> TrSrc { TrSrc t; bf16_t* gRB = (bf16_t*)(gws + WS_RB); bf16_t* gWB = (bf16_t*)(gws + WS_WB);
#define TRJ(cnt, srcp, ldw_, col0, ncols, dstp) if (r < (cnt)) { const int nb = (ncols) / 32, kb = r / nb, n0 = (r % nb) * 32; \
                t.src = (srcp) + (size_t)(kb * 64) * (ldw_) + (col0) + n0; t.ldw = (ldw_); t.dst = (dstp) + (size_t)n0 * DM + kb * 64; t.dld = DM; return t; } r -= (cnt);
            TRJ(J_U, gw_in, INW, 0, 512, gRB + (size_t)(PN_W + WP_U) * 256 * DM)
            TRJ(J_Q, gw_in, INW, 512, 512, gRB + (size_t)(PN_W + WP_Q) * 256 * DM)
            TRJ(J_K, gw_in, INW, 1024, 512, gRB + (size_t)(PN_W + WP_K) * 256 * DM)
            TRJ(J_V, gw_in, INW, 1536, 1024, gRB + (size_t)(PN_W + WP_V) * 256 * DM)
            TRJ(J_R, gw_in, INW, 2560, 1024, gRB + (size_t)(PN_W + WP_R) * 256 * DM)
            TRJ(J_MQ, gw_in, INW, 3600, 512, gRB + (size_t)(PN_W + WP_MQ) * 256 * DM)
            TRJ(J_G, gw_gate, 6144, 0, 6144, gRB + (size_t)(PN_W + WP_G) * 256 * DM)
            TRJ(J_MK, gmk, 512, 0, 512, gRB + (size_t)(PN_W + WP_MK) * 256 * DM)
            TRJ(J_MV, gmv, 512, 0, 512, gRB + (size_t)(PN_W + WP_MV) * 256 * DM)
#undef TRJ
            if (r < J_BG) { const int kb = r / 64, n0 = (r % 64) * 32; t.src = gbg + (size_t)(kb * 64) * 2048 + n0; t.ldw = 2048; t.dst = gWB + (size_t)n0 * DM + 512 + kb * 64; t.dld = DM; return t; } r -= J_BG;
            if (r < J_BM) { const int kb = r / 64, n0 = (r % 64) * 32; t.src = gbm + (size_t)(kb * 64) * 2048 + n0; t.ldw = 2048; t.dst = gWB + (size_t)n0 * DM + 1536 + kb * 64; t.dld = DM; return t; } r -= J_BM;
            { const int kb = r / 16, n0 = (r % 16) * 32; t.src = gvs + (size_t)(kb * 64) * 512 + n0; t.ldw = 512; t.dst = (bf16_t*)(gws + WS_VST) + (size_t)n0 * 8192 + kb * 64; t.dld = 8192; return t; }
        }, 0, NTRP, gw, NGW, scr, lane);
    }
    {
        const float* gx0 = as_global(a.in[0]); const float* gx1 = as_global(a.in[1]); const float* gx2 = as_global(a.in[2]); const float* gg0 = as_global(a.in[11]); const float* gg1 = as_global(a.in[8]);
        bf16_t* gRB = (bf16_t*)(as_global(ws) + WS_RB);
        auto src = [&](int r) -> const float* { return r < NPROMPT ? gx0 + (size_t)r * DM : (r < MTOK ? gx1 + (size_t)(r - NPROMPT) * DM : gx2 + (size_t)(r - MTOK) * DM); };
        f32x4 nva[8], nvb[8], gk[8];
#pragma unroll
        for (int j2 = 0; j2 < 8; ++j2) gk[j2] = ((const f32x4*)gg0)[lane + 64 * j2];
        auto issue = [&](f32x4 (&nvx)[8], int rr) { const f32x4* xr = (const f32x4*)src(rr) + lane;
#pragma unroll
            for (int j2 = 0; j2 < 8; ++j2) nvx[j2] = xr[64 * j2]; };
        auto rowdo = [&](const f32x4 (&nvx)[8], int rr) {
            f32x4 v[8]; float sq = 0.f;
#pragma unroll
            for (int j2 = 0; j2 < 8; ++j2) { v[j2] = nvx[j2]; sq += (v[j2].x * v[j2].x + v[j2].y * v[j2].y) + (v[j2].z * v[j2].z + v[j2].w * v[j2].w); }
            const float rstd = 1.0f / sqrtf(wave_sum(sq) * (1.f / DM) + EPS);
            u32x2* o8 = (u32x2*)(gRB + (size_t)(rr < MTOK ? rr : PN_MN * 256 + (rr - MTOK)) * DM) + lane;
            if (rr < MTOK) {
#pragma unroll
                for (int j2 = 0; j2 < 8; ++j2) { const f32x4 gq = gk[j2]; u32x2 w; w.x = pk_bf16(v[j2].x * rstd * gq.x, v[j2].y * rstd * gq.y); w.y = pk_bf16(v[j2].z * rstd * gq.z, v[j2].w * rstd * gq.w); o8[64 * j2] = w; }
            } else {
#pragma unroll
                for (int j2 = 0; j2 < 8; ++j2) { const f32x4 gq = ((const f32x4*)gg1)[lane + 64 * j2]; u32x2 w; w.x = pk_bf16(v[j2].x * rstd * gq.x, v[j2].y * rstd * gq.y); w.y = pk_bf16(v[j2].z * rstd * gq.z, v[j2].w * rstd * gq.w); o8[64 * j2] = w; }
            } };
        int r = gw;
        if (r < NROW) issue(nva, r);
        if (r + NGW < NROW) issue(nvb, r + NGW);
        for (; r < NROW; r += 2 * NGW) {
            { f32x4 t[8];
#pragma unroll
              for (int j2 = 0; j2 < 8; ++j2) t[j2] = nva[j2];
              if (r + 2 * NGW < NROW) issue(nva, r + 2 * NGW);
              rowdo(t, r); }
            if (r + NGW < NROW) { f32x4 t[8];
#pragma unroll
              for (int j2 = 0; j2 < 8; ++j2) t[j2] = nvb[j2];
              if (r + 3 * NGW < NROW) issue(nvb, r + 3 * NGW);
              rowdo(t, r + NGW); }
        }
    }
    for (int r = gw; r < J_WC; r += NGW) {
        const int g = r >> 9, cb = (r >> 5) & 15, nb = r & 31, n = nb * 64 + lane;
        const float* wp = a.in[13] + ((size_t)g * 128 + cb * 8) * 128; const float* sp = a.in[14] + g * 128; const float* wb = a.in[20] + (size_t)g * 128 * DM + n;
        f32x4 wq[4]; float sq[2];
#pragma unroll
        for (int k = 0; k < 4; ++k) wq[k] = ((const f32x4*)wp)[lane + 64 * k];
        sq[0] = sp[lane]; sq[1] = sp[64 + lane];
        float acc8[8];
#pragma unroll
        for (int i = 0; i < 8; ++i) acc8[i] = 0.f;
#pragma unroll
        for (int h2 = 0; h2 < 4; ++h2) {
            float xb[32];
#pragma unroll
            for (int d = 0; d < 32; ++d) xb[d] = wb[(size_t)(32 * h2 + d) * DM];
#pragma unroll
            for (int dd = 0; dd < 32; ++dd) { const int d = 32 * h2 + dd;
                const float x = xb[dd] * __int_as_float(__builtin_amdgcn_readlane(__float_as_int(sq[d >> 6]), d & 63));
#pragma unroll
                for (int i = 0; i < 8; ++i) { const int e = i * 128 + d;
                    acc8[i] += __int_as_float(__builtin_amdgcn_readlane(__float_as_int(wq[e >> 8][e & 3]), (e >> 2) & 63)) * x; } }
        }
        u32x4 o; o.x = pk_bf16(acc8[0], acc8[1]); o.y = pk_bf16(acc8[2], acc8[3]); o.z = pk_bf16(acc8[4], acc8[5]); o.w = pk_bf16(acc8[6], acc8[7]);
        *(u32x4*)(WBt + (size_t)n * DM + g * 128 + cb * 8) = o;
    }
    for (int it = NTRP + gw; it < NITEMS; it += NGW) {
        int r = it - NTRP;
        if (r < J_WC) continue;
        r -= J_WC;
        if (r < NROW) continue;
        r -= NROW;
        if (r < NKS) {
            const f32x4* s = (const f32x4*)(a.in[6] + (size_t)r * 2048) + lane; u32x2* d = (u32x2*)((bf16_t*)(ws + WS_KS) + (size_t)r * 2048) + lane;
#pragma unroll
            for (int j = 0; j < 8; ++j) { const f32x4 v = s[64 * j]; u32x2 w; w.x = pk_bf16(v.x, v.y); w.y = pk_bf16(v.z, v.w); d[64 * j] = w; }
            continue; } r -= NKS;
        {
            bf16_t* P = RB + (size_t)(PN_W + WP_ALR) * 256 * DM;
            u32x4 z = {0u, 0u, 0u, 0u}; u32x4* d = (u32x4*)(P + (size_t)(16 + r) * DM) + lane;
#pragma unroll
            for (int j = 0; j < 4; ++j) d[64 * j] = z;
            if (r < 16) { for (int k = lane; k < DM; k += 64) P[(size_t)r * DM + k] = (bf16_t)(pk_bf16(w_in[(size_t)k * INW + 3584 + r], 0.f) & 0xffffu); }
        }
    }
}

DI void pool_item(const Args& a, int item, int lane) {
    const float* U = (const float*)(a.ws + WS_U); bf16_t* BR = (bf16_t*)(a.ws + WS_BR);
    const int w = 2 << (lane >> 4), c0 = lane * 8, m0 = item * 8;
    int t0, T, seq0; const float* hist = nullptr; float* po;
    if (m0 < NPROMPT) { t0 = m0 & 4095; T = 4096; seq0 = m0 - t0; po = a.out + O_POOLP + (size_t)(m0 >> 12) * 15 * 512; }
    else { t0 = (m0 - NPROMPT) & 31; T = 32; seq0 = m0 - t0; const int b = (m0 - NPROMPT) >> 5; hist = a.in[3] + (size_t)b * 15 * 512; po = a.out + O_POOLS + (size_t)b * 15 * 512; }
    auto rowp = [&](int tt) -> const float* { return tt >= 0 ? U + (size_t)(seq0 + tt) * 512 + c0 : ((hist && tt >= -15) ? hist + (size_t)(15 + tt) * 512 + c0 : nullptr); };
    const f32x4 z4 = {0.f, 0.f, 0.f, 0.f};
    f32x4 x0[8], x1[8], y0[8], y1[8];
#pragma unroll
    for (int i = 0; i < 8; ++i) { const float* p = rowp(t0 + i); x0[i] = *(const f32x4*)p; x1[i] = *(const f32x4*)(p + 4);
        const float* q = rowp(t0 + i - w); if (q) { y0[i] = *(const f32x4*)q; y1[i] = *(const f32x4*)(q + 4); } else { y0[i] = z4; y1[i] = z4; } }
    f32x4 s0 = z4, s1 = z4;
#pragma unroll
    for (int j = 1; j <= 16; ++j) { if (j <= w) { const float* p = rowp(t0 - j); if (p) { s0 += *(const f32x4*)p; s1 += *(const f32x4*)(p + 4); } } }
#pragma unroll
    for (int i = 0; i < 8; ++i) {
        const int t = t0 + i, m = m0 + i;
        s0 += x0[i] - y0[i]; s1 += x1[i] - y1[i];
        const float cnt = hist ? (float)w : (float)((t + 1) < w ? (t + 1) : w), ic = 1.0f / cnt;
        const f32x4 d0 = s0 * ic - x0[i], d1 = s1 * ic - x1[i];
        *(u32x4*)(BR + (size_t)m * DM + c0) = pack8(d0, d1);
        if (t >= T - 15) { float* q = po + (size_t)(t - (T - 15)) * 512 + c0; *(f32x4*)q = x0[i]; *(f32x4*)(q + 4) = x1[i]; }
    }
}

DI void mem_attn_item(const Args& a, int item, int lane) {
    const int r32 = lane & 31, hh = lane >> 5;
    const bf16_t* MQ = (const bf16_t*)(a.ws + WS_MQ); bf16_t* BR = (bf16_t*)(a.ws + WS_BR);
    int m0, h; const bf16_t* Kb; const bf16_t* VT; size_t ldv;
    if (item < 2048) { const int b = item >> 9, rem = item & 511; h = rem >> 7; m0 = b * 4096 + (rem & 127) * 32;
        Kb = (const bf16_t*)(a.ws + WS_KM) + (size_t)b * 256 * 512 + h * 128; VT = (const bf16_t*)(a.ws + WS_VMT) + (size_t)h * 128 * 1024 + b * 256; ldv = 1024; }
    else { const int j = item - 2048, b = j >> 2; h = j & 3; m0 = NPROMPT + b * 32;
        Kb = (const bf16_t*)(a.ws + WS_KS) + (size_t)b * 256 * 512 + h * 128; VT = (const bf16_t*)(a.ws + WS_VST) + (size_t)h * 128 * 8192 + b * 256; ldv = 8192; }
    bf16x8 qf[8];
#pragma unroll
    for (int s = 0; s < 8; ++s) qf[s] = *(const bf16x8*)(MQ + (size_t)(m0 + r32) * 512 + h * 128 + 16 * s + 8 * hh);
    f32x16 sc[8];
    bf16x8 kA[4], kB[4];
#pragma unroll
    for (int s = 0; s < 4; ++s) kA[s] = *(const bf16x8*)(Kb + (size_t)r32 * 512 + 16 * s + 8 * hh);
    f32x16 c;
#pragma unroll
    for (int g = 0; g < 16; ++g) {
        const int kt = g >> 1, sg = g & 1;
        if (sg == 0) {
#pragma unroll
            for (int i = 0; i < 16; ++i) c[i] = 0.f; }
        if (g + 1 < 16) { const int kt1 = (g + 1) >> 1, sg1 = (g + 1) & 1;
#pragma unroll
            for (int s = 0; s < 4; ++s) { const bf16x8 v = *(const bf16x8*)(Kb + (size_t)(32 * kt1 + r32) * 512 + 16 * (4 * sg1 + s) + 8 * hh); if (g & 1) kA[s] = v; else kB[s] = v; } }
        asm volatile("" ::: "memory");
#pragma unroll
        for (int s = 0; s < 4; ++s) c = __builtin_amdgcn_mfma_f32_32x32x16_bf16((g & 1) ? kB[s] : kA[s], qf[4 * sg + s], c, 0, 0, 0);
        if (sg == 1) sc[kt] = c;
    }
    float mx = -3.0e38f;
#pragma unroll
    for (int kt = 0; kt < 8; ++kt)
#pragma unroll
        for (int i = 0; i < 16; ++i) mx = fmaxf(mx, sc[kt][i]);
    mx = fmaxf(mx, __shfl_xor(mx, 32));
    float l = 0.f;
    bf16x8 pf[8][2];
#pragma unroll
    for (int kt = 0; kt < 8; ++kt) {
        float p[16];
#pragma unroll
        for (int i = 0; i < 16; ++i) { p[i] = __builtin_amdgcn_exp2f(sc[kt][i] - mx); l += p[i]; }
#pragma unroll
        for (int s = 0; s < 2; ++s) { u32x4 w; w.x = pk_bf16(p[8 * s], p[8 * s + 1]); w.y = pk_bf16(p[8 * s + 2], p[8 * s + 3]); w.z = pk_bf16(p[8 * s + 4], p[8 * s + 5]); w.w = pk_bf16(p[8 * s + 6], p[8 * s + 7]);
            pf[kt][s] = __builtin_bit_cast(bf16x8, w); }
    }
    l += __shfl_xor(l, 32);
    const float il = 1.0f / l;
#pragma unroll
    for (int dt = 0; dt < 4; ++dt) {
        f32x16 o;
#pragma unroll
        for (int i = 0; i < 16; ++i) o[i] = 0.f;
        const bf16_t* vr = VT + (size_t)(32 * dt + r32) * ldv + 4 * hh;
#pragma unroll
        for (int kt = 0; kt < 8; ++kt)
#pragma unroll
            for (int s = 0; s < 2; ++s) {
                const s16x4 lo = *(const s16x4*)(vr + 32 * kt + 16 * s), hi = *(const s16x4*)(vr + 32 * kt + 16 * s + 8);
                const bf16x8 vf = __builtin_shufflevector(lo, hi, 0, 1, 2, 3, 4, 5, 6, 7);
                o = __builtin_amdgcn_mfma_f32_32x32x16_bf16(vf, pf[kt][s], o, 0, 0, 0);
            }
        bf16_t* op = BR + (size_t)(m0 + r32) * DM + 1536 + h * 128 + 32 * dt + 4 * hh;
#pragma unroll
        for (int g = 0; g < 4; ++g) { u32x2 w; w.x = pk_bf16(o[4 * g] * il, o[4 * g + 1] * il); w.y = pk_bf16(o[4 * g + 2] * il, o[4 * g + 3] * il); *(u32x2*)(op + 8 * g) = w; }
    }
}

constexpr int GL_QE = 0, GL_KE = 17408, GL_KT = 34816, GL_AT = 53248, GL_BL = 62464, GL_QP = 95232, GL_DEC = 97280, GL_SSQ = 97792, GL_RSTD = 99840, GL_ALR = 100096, GL_WG = 104192;
DI int crow(int reg, int hh) { return (reg & 3) + 8 * (reg >> 2) + 4 * hh; }
template <int CT>
DI void gla_sequence(const Args& a, LAS unsigned char* lds, int tok0, int nchunks, int h, const float* s_in, float* s_out) {
    const int tid = threadIdx.x, w = __builtin_amdgcn_readfirstlane(tid >> 6), lane = tid & 63, r32 = lane & 31, hh = lane >> 5;
    constexpr int QR = CT / 4, NTT = CT / 32, NKS = CT / 16;
    const bf16_t* Qg = (const bf16_t*)(a.ws + WS_Q); const bf16_t* Kg = (const bf16_t*)(a.ws + WS_K); const float* ALRg = (const float*)(a.ws + WS_ALR);
    const bf16_t* VRT = (const bf16_t*)(a.ws + WS_VRT); bf16_t* BR = (bf16_t*)(a.ws + WS_BR);
    const int vcol = h * 256 + 32 * w + r32;
    const bf16_t* vrow = VRT + (size_t)vcol * MTOK; const bf16_t* rrow = VRT + (size_t)(1024 + vcol) * MTOK;
    const float ghead = a.in[17][vcol];
    const int c1 = tid & 127, tq = tid >> 7, t2 = tid >> 3, c0 = (tid & 7) * 16;
    for (int i = tid; i < 16 * 128; i += 512) *(LAS float*)(lds + GL_WG + i * 4) = a.in[15][(size_t)(i >> 7) * 512 + h * 128 + (i & 127)];
    const float bgc = a.in[16][h * 128 + c1];
    f32x16 S[4];
#pragma unroll
    for (int kt = 0; kt < 4; ++kt)
#pragma unroll
        for (int i = 0; i < 16; ++i) S[kt][i] = s_in ? s_in[(size_t)(32 * kt + crow(i, hh)) * 256 + 32 * w + r32] : 0.f;
    f32x4 an = {0.f, 0.f, 0.f, 0.f};
    if (tid < CT * 4) { an = *(const f32x4*)(ALRg + (size_t)(tok0 + (tid >> 2)) * 16 + (tid & 3) * 4); *(LAS f32x4*)(lds + GL_ALR + tid * 16) = an; }
    LDS_WAIT(); __syncthreads();
    for (int n = 0; n < nchunks; ++n) {
        const int t0 = tok0 + n * CT;
        bf16x8 qc[2] = {}, kc[2] = {}, vf[NKS];
        if (t2 < CT) { const size_t o = (size_t)(t0 + t2) * 512 + h * 128 + c0; qc[0] = *(const bf16x8*)(Qg + o); qc[1] = *(const bf16x8*)(Qg + o + 8); kc[0] = *(const bf16x8*)(Kg + o); kc[1] = *(const bf16x8*)(Kg + o + 8); }
#pragma unroll
        for (int s = 0; s < NKS; ++s) vf[s] = *(const bf16x8*)(vrow + t0 + 16 * s + 8 * hh);
        if (n + 1 < nchunks && tid < CT * 4) an = *(const f32x4*)(ALRg + (size_t)(t0 + CT + (tid >> 2)) * 16 + (tid & 3) * 4);
        {
            float run = 0.f;
#pragma unroll 4
            for (int i = 0; i < QR; ++i) { const int t = tq * QR + i; const LAS f32x4* ar = (const LAS f32x4*)(lds + GL_ALR + t * 64);
                float pre = bgc;
#pragma unroll
                for (int j4 = 0; j4 < 4; ++j4) { const f32x4 x = ar[j4]; const LAS float* wgp = (const LAS float*)(lds + GL_WG + (4 * j4 * 128 + c1) * 4); pre += x[0] * wgp[0] + x[1] * wgp[128] + x[2] * wgp[256] + x[3] * wgp[384]; }
                const float ls = fminf(pre, 0.f) - __logf(1.0f + __expf(-fabsf(pre)));
                run += ls * (1.0f / 16.0f);
                *(LAS float*)(lds + GL_BL + (t * 128 + c1) * 4) = run; }
            *(LAS float*)(lds + GL_QP + (tq * 128 + c1) * 4) = run;
        }
        LDS_WAIT(); __syncthreads();
        if (t2 < CT) {
            const int tqr = t2 / QR;
#pragma unroll
            for (int half = 0; half < 2; ++half) {
                float bl[8], bb[8];
#pragma unroll
                for (int i = 0; i < 8; ++i) { bl[i] = 0.f; bb[i] = 0.f; }
#pragma unroll
                for (int q4 = 0; q4 < 4; ++q4) {
                    const LAS f32x4* qp = (const LAS f32x4*)(lds + GL_QP + (q4 * 128 + c0 + 8 * half) * 4); const f32x4 x0 = qp[0], x1 = qp[1];
#pragma unroll
                    for (int i = 0; i < 4; ++i) { bl[i] += x0[i]; bl[4 + i] += x1[i]; if (q4 < tqr) { bb[i] += x0[i]; bb[4 + i] += x1[i]; } }
                }
                { const LAS f32x4* bp = (const LAS f32x4*)(lds + GL_BL + (t2 * 128 + c0 + 8 * half) * 4); const f32x4 x0 = bp[0], x1 = bp[1];
#pragma unroll
                  for (int i = 0; i < 4; ++i) { bb[i] += x0[i]; bb[4 + i] += x1[i]; } }
                float qe[8], ke[8], kt[8];
#pragma unroll
                for (int i = 0; i < 8; ++i) { const float qv = bf2f((bf16_t)qc[half][i]), kv = bf2f((bf16_t)kc[half][i]);
                    qe[i] = qv * 0.08838834764831845f * __expf(bb[i]); ke[i] = kv * __expf(-bb[i]); kt[i] = kv * __expf(bl[i] - bb[i]); }
                u32x4 wq, wk; wq.x = pk_bf16(qe[0], qe[1]); wq.y = pk_bf16(qe[2], qe[3]); wq.z = pk_bf16(qe[4], qe[5]); wq.w = pk_bf16(qe[6], qe[7]);
                wk.x = pk_bf16(ke[0], ke[1]); wk.y = pk_bf16(ke[2], ke[3]); wk.z = pk_bf16(ke[4], ke[5]); wk.w = pk_bf16(ke[6], ke[7]);
                *(LAS u32x4*)(lds + GL_QE + t2 * 272 + (c0 + 8 * half) * 2) = wq;
                *(LAS u32x4*)(lds + GL_KE + t2 * 272 + (c0 + 8 * half) * 2) = wk;
#pragma unroll
                for (int i = 0; i < 8; i += 2) { const unsigned pw = pk_bf16(kt[i], kt[i + 1]);
                    *(LAS bf16_t*)(lds + GL_KT + (c0 + 8 * half + i) * 144 + t2 * 2) = (bf16_t)(pw & 0xffffu);
                    *(LAS bf16_t*)(lds + GL_KT + (c0 + 8 * half + i + 1) * 144 + t2 * 2) = (bf16_t)(pw >> 16); }
                if (t2 == CT - 1) {
#pragma unroll
                    for (int i = 0; i < 8; ++i) *(LAS float*)(lds + GL_DEC + (c0 + 8 * half + i) * 4) = __expf(bl[i]); }
            }
        }
        LDS_WAIT(); __syncthreads();
        if (w < (NTT == 2 ? 3 : 1)) {
            const int ti = (w == 0) ? 0 : 1, tj = (w == 2) ? 1 : 0;
            f32x16 c;
#pragma unroll
            for (int i = 0; i < 16; ++i) c[i] = 0.f;
#pragma unroll
            for (int s = 0; s < 8; ++s) {
                const bf16x8 af = *(const LAS bf16x8*)(lds + GL_QE + (32 * ti + r32) * 272 + (16 * s + 8 * hh) * 2);
                const bf16x8 bfr = *(const LAS bf16x8*)(lds + GL_KE + (32 * tj + r32) * 272 + (16 * s + 8 * hh) * 2);
                c = __builtin_amdgcn_mfma_f32_32x32x16_bf16(af, bfr, c, 0, 0, 0);
            }
            const int tcol = 32 * tj + r32;
#pragma unroll
            for (int i = 0; i < 16; i += 2) { const int tr0 = 32 * ti + crow(i, hh), tr1 = tr0 + 1;
                const unsigned pw = pk_bf16(tcol <= tr0 ? c[i] : 0.f, tcol <= tr1 ? c[i + 1] : 0.f);
                *(LAS bf16_t*)(lds + GL_AT + tr0 * 144 + tcol * 2) = (bf16_t)(pw & 0xffffu);
                *(LAS bf16_t*)(lds + GL_AT + tr1 * 144 + tcol * 2) = (bf16_t)(pw >> 16); }
        }
        LDS_WAIT(); __syncthreads();
        f32x16 o[NTT];
#pragma unroll
        for (int tt = 0; tt < NTT; ++tt) {
            f32x16 c;
#pragma unroll
            for (int i = 0; i < 16; ++i) c[i] = 0.f;
#pragma unroll
            for (int s = 0; s < 2 * (tt + 1); ++s) {
                const bf16x8 af = *(const LAS bf16x8*)(lds + GL_AT + (32 * tt + r32) * 144 + (16 * s + 8 * hh) * 2);
                c = __builtin_amdgcn_mfma_f32_32x32x16_bf16(af, vf[s], c, 0, 0, 0);
            }
#pragma unroll
            for (int kt = 0; kt < 4; ++kt)
#pragma unroll
                for (int s = 0; s < 2; ++s) {
                    u32x4 pw; pw.x = pk_bf16(S[kt][8 * s], S[kt][8 * s + 1]); pw.y = pk_bf16(S[kt][8 * s + 2], S[kt][8 * s + 3]); pw.z = pk_bf16(S[kt][8 * s + 4], S[kt][8 * s + 5]); pw.w = pk_bf16(S[kt][8 * s + 6], S[kt][8 * s + 7]);
                    const bf16x8 sf = __builtin_bit_cast(bf16x8, pw);
                    const LAS unsigned char* qa = lds + GL_QE + (32 * tt + r32) * 272 + (32 * kt + 16 * s + 4 * hh) * 2;
                    const s16x4 lo = *(const LAS s16x4*)qa, hi = *(const LAS s16x4*)(qa + 16);
                    const bf16x8 af = __builtin_shufflevector(lo, hi, 0, 1, 2, 3, 4, 5, 6, 7);
                    c = __builtin_amdgcn_mfma_f32_32x32x16_bf16(af, sf, c, 0, 0, 0);
                }
            o[tt] = c;
        }
#pragma unroll
        for (int tt = 0; tt < NTT; ++tt) {
            float x[16];
#pragma unroll
            for (int i = 0; i < 16; ++i) x[i] = o[tt][i] * o[tt][i];
#pragma unroll
            for (int i = 0; i < 8; ++i) { const bool up = (lane & 16) != 0; const float keep = up ? x[i + 8] : x[i], send = up ? x[i] : x[i + 8]; x[i] = keep + __shfl_xor(send, 16); }
#pragma unroll
            for (int i = 0; i < 4; ++i) { const bool up = (lane & 8) != 0; const float keep = up ? x[i + 4] : x[i], send = up ? x[i] : x[i + 4]; x[i] = keep + __shfl_xor(send, 8); }
#pragma unroll
            for (int i = 0; i < 2; ++i) { const bool up = (lane & 4) != 0; const float keep = up ? x[i + 2] : x[i], send = up ? x[i] : x[i + 2]; x[i] = keep + __shfl_xor(send, 4); }
            { const bool up = (lane & 2) != 0; const float keep = up ? x[1] : x[0], send = up ? x[0] : x[1]; x[0] = keep + __shfl_xor(send, 2); }
            x[0] += __shfl_xor(x[0], 1);
            if ((lane & 1) == 0) { const int reg = (r32 >> 1) & 15; *(LAS float*)(lds + GL_SSQ + (w * 64 + 32 * tt + crow(reg, hh)) * 4) = x[0]; }
        }
        LDS_WAIT(); __syncthreads();
        if (tid < CT) { float s = 0.f;
#pragma unroll
            for (int ww = 0; ww < 8; ++ww) s += *(const LAS float*)(lds + GL_SSQ + (ww * 64 + tid) * 4);
            *(LAS float*)(lds + GL_RSTD + tid * 4) = 1.0f / sqrtf(s * (1.0f / 256.0f) + EPS); }
        LDS_WAIT(); __syncthreads();
#pragma unroll
        for (int tt = 0; tt < NTT; ++tt)
#pragma unroll
            for (int g4 = 0; g4 < 4; ++g4) {
                const int tb = 32 * tt + 8 * g4 + 4 * hh;
                const u32x2 rw = *(const u32x2*)(rrow + t0 + tb);
                const float rv[4] = {bf_lo(rw.x), bf_hi(rw.x), bf_lo(rw.y), bf_hi(rw.y)};
#pragma unroll
                for (int e = 0; e < 4; ++e) { const float rs = *(const LAS float*)(lds + GL_RSTD + (tb + e) * 4);
                    const float val = o[tt][4 * g4 + e] * rs * ghead * rv[e];
                    BR[(size_t)(t0 + tb + e) * DM + 512 + vcol] = (bf16_t)(pk_bf16(val, 0.f) & 0xffffu); }
            }
#pragma unroll
        for (int kt = 0; kt < 4; ++kt) {
#pragma unroll
            for (int i = 0; i < 16; ++i) S[kt][i] *= *(const LAS float*)(lds + GL_DEC + (32 * kt + crow(i, hh)) * 4);
#pragma unroll
            for (int s = 0; s < NKS; ++s) {
                const bf16x8 af = *(const LAS bf16x8*)(lds + GL_KT + (32 * kt + r32) * 144 + (16 * s + 8 * hh) * 2);
                S[kt] = __builtin_amdgcn_mfma_f32_32x32x16_bf16(af, vf[s], S[kt], 0, 0, 0);
            }
        }
        if (n + 1 < nchunks && tid < CT * 4) *(LAS f32x4*)(lds + GL_ALR + tid * 16) = an;
        LDS_WAIT(); __syncthreads();
    }
#pragma unroll
    for (int kt = 0; kt < 4; ++kt)
#pragma unroll
        for (int i = 0; i < 16; ++i) s_out[(size_t)(32 * kt + crow(i, hh)) * 256 + 32 * w + r32] = S[kt][i];
}

DI void gla_prep_chunk(const Args& a, LAS unsigned char* lds, int t0, int h) {
    constexpr int CT = 64, QR = 16;
    const int tid = threadIdx.x, w = __builtin_amdgcn_readfirstlane(tid >> 6), lane = tid & 63, r32 = lane & 31, hh = lane >> 5;
    bf16_t* Qg = (bf16_t*)(a.ws + WS_Q); bf16_t* Kg = (bf16_t*)(a.ws + WS_K); const float* ALRg = (const float*)(a.ws + WS_ALR); bf16_t* BR = (bf16_t*)(a.ws + WS_BR);
    const int c1 = tid & 127, tq = tid >> 7, t2 = tid >> 3, c0 = (tid & 7) * 16;
    const float bgc = a.in[16][h * 128 + c1];
    bf16x8 qc[2], kc[2];
    { const size_t o = (size_t)(t0 + t2) * 512 + h * 128 + c0; qc[0] = *(const bf16x8*)(Qg + o); qc[1] = *(const bf16x8*)(Qg + o + 8); kc[0] = *(const bf16x8*)(Kg + o); kc[1] = *(const bf16x8*)(Kg + o + 8); }
    if (tid < CT * 4) *(LAS f32x4*)(lds + GL_ALR + tid * 16) = *(const f32x4*)(ALRg + (size_t)(t0 + (tid >> 2)) * 16 + (tid & 3) * 4);
    LDS_WAIT(); __syncthreads();
    {
        float run = 0.f;
#pragma unroll 4
        for (int i = 0; i < QR; ++i) { const int t = tq * QR + i; const LAS f32x4* ar = (const LAS f32x4*)(lds + GL_ALR + t * 64);
            float pre = bgc;
#pragma unroll
            for (int j4 = 0; j4 < 4; ++j4) { const f32x4 x = ar[j4]; const LAS float* wgp = (const LAS float*)(lds + GL_WG + (4 * j4 * 128 + c1) * 4); pre += x[0] * wgp[0] + x[1] * wgp[128] + x[2] * wgp[256] + x[3] * wgp[384]; }
            const float ls = fminf(pre, 0.f) - __logf(1.0f + __expf(-fabsf(pre)));
            run += ls * (1.0f / 16.0f);
            *(LAS float*)(lds + GL_BL + (t * 128 + c1) * 4) = run; }
        *(LAS float*)(lds + GL_QP + (tq * 128 + c1) * 4) = run;
    }
    LDS_WAIT(); __syncthreads();
    {
        const int tqr = t2 / QR;
#pragma unroll
        for (int half = 0; half < 2; ++half) {
            float bl[8], bb[8];
#pragma unroll
            for (int i = 0; i < 8; ++i) { bl[i] = 0.f; bb[i] = 0.f; }
#pragma unroll
            for (int q4 = 0; q4 < 4; ++q4) {
                const LAS f32x4* qp = (const LAS f32x4*)(lds + GL_QP + (q4 * 128 + c0 + 8 * half) * 4); const f32x4 x0 = qp[0], x1 = qp[1];
#pragma unroll
                for (int i = 0; i < 4; ++i) { bl[i] += x0[i]; bl[4 + i] += x1[i]; if (q4 < tqr) { bb[i] += x0[i]; bb[4 + i] += x1[i]; } }
            }
            { const LAS f32x4* bp = (const LAS f32x4*)(lds + GL_BL + (t2 * 128 + c0 + 8 * half) * 4); const f32x4 x0 = bp[0], x1 = bp[1];
#pragma unroll
              for (int i = 0; i < 4; ++i) { bb[i] += x0[i]; bb[4 + i] += x1[i]; } }
            float qe[8], ke[8], kt[8];
#pragma unroll
            for (int i = 0; i < 8; ++i) { const float qv = bf2f((bf16_t)qc[half][i]), kv = bf2f((bf16_t)kc[half][i]);
                qe[i] = qv * 0.08838834764831845f * __expf(bb[i]); ke[i] = kv * __expf(-bb[i]); kt[i] = kv * __expf(bl[i] - bb[i]); }
            u32x4 wq, wk; wq.x = pk_bf16(qe[0], qe[1]); wq.y = pk_bf16(qe[2], qe[3]); wq.z = pk_bf16(qe[4], qe[5]); wq.w = pk_bf16(qe[6], qe[7]);
            wk.x = pk_bf16(ke[0], ke[1]); wk.y = pk_bf16(ke[2], ke[3]); wk.z = pk_bf16(ke[4], ke[5]); wk.w = pk_bf16(ke[6], ke[7]);
            *(LAS u32x4*)(lds + GL_QE + t2 * 272 + (c0 + 8 * half) * 2) = wq;
            *(LAS u32x4*)(lds + GL_KE + t2 * 272 + (c0 + 8 * half) * 2) = wk;
            *(u32x4*)(Qg + (size_t)(t0 + t2) * 512 + h * 128 + c0 + 8 * half) = wq;
#pragma unroll
            for (int i = 0; i < 8; i += 2) { const unsigned pw = pk_bf16(kt[i], kt[i + 1]);
                *(LAS bf16_t*)(lds + GL_KT + (c0 + 8 * half + i) * 144 + t2 * 2) = (bf16_t)(pw & 0xffffu);
                *(LAS bf16_t*)(lds + GL_KT + (c0 + 8 * half + i + 1) * 144 + t2 * 2) = (bf16_t)(pw >> 16); }
            if (t2 == CT - 1) {
                f32x4 d0, d1;
#pragma unroll
                for (int i = 0; i < 4; ++i) { d0[i] = __expf(bl[i]); d1[i] = __expf(bl[4 + i]); }
                const int c = c0 + 8 * half; float* dp = (float*)(BR + (size_t)(t0 + (c >> 5)) * DM + 512 + h * 256 + 64) + (c & 31);
                *(f32x4*)dp = d0; *(f32x4*)(dp + 4) = d1; }
        }
    }
    LDS_WAIT(); __syncthreads();
#pragma unroll
    for (int i = 0; i < 2; ++i) { const int x = tid + 512 * i, c = x >> 3, j = x & 7;
        const u32x4 v = *(const LAS u32x4*)(lds + GL_KT + c * 144 + j * 16);
        *(u32x4*)(Kg + (size_t)(t0 + (c >> 1)) * 512 + h * 128 + (c & 1) * 64 + j * 8) = v; }
    if (w < 3) {
        const int ti = (w == 0) ? 0 : 1, tj = (w == 2) ? 1 : 0;
        f32x16 c;
#pragma unroll
        for (int i = 0; i < 16; ++i) c[i] = 0.f;
#pragma unroll
        for (int s = 0; s < 8; ++s) {
            const bf16x8 af = *(const LAS bf16x8*)(lds + GL_QE + (32 * ti + r32) * 272 + (16 * s + 8 * hh) * 2);
            const bf16x8 bfr = *(const LAS bf16x8*)(lds + GL_KE + (32 * tj + r32) * 272 + (16 * s + 8 * hh) * 2);
            c = __builtin_amdgcn_mfma_f32_32x32x16_bf16(af, bfr, c, 0, 0, 0);
        }
        const int tcol = 32 * tj + r32;
#pragma unroll
        for (int i = 0; i < 16; i += 2) { const int tr0 = 32 * ti + crow(i, hh), tr1 = tr0 + 1;
            const unsigned pw = pk_bf16(tcol <= tr0 ? c[i] : 0.f, tcol <= tr1 ? c[i + 1] : 0.f);
            *(LAS bf16_t*)(lds + GL_AT + tr0 * 144 + tcol * 2) = (bf16_t)(pw & 0xffffu);
            *(LAS bf16_t*)(lds + GL_AT + tr1 * 144 + tcol * 2) = (bf16_t)(pw >> 16); }
    }
    LDS_WAIT(); __syncthreads();
    { const int t = tid >> 3, j = tid & 7; const u32x4 v = *(const LAS u32x4*)(lds + GL_AT + t * 144 + j * 16);
      *(u32x4*)(BR + (size_t)(t0 + t) * DM + 512 + h * 256 + j * 8) = v; }
}

constexpr int GB_IMG = 41984, GB_KT = 16384, GB_AT = 32768, GB_DEC = 40960, GB_SSQ = 2 * GB_IMG, GB_OST = GB_SSQ + 4096, GB_RST = GB_OST + 32768;
constexpr int GLA_SEGS = 8, GLA_SEG_CH = 8, GLA_NAGG = GLA_SEGS - 1;
template <int MODE>
DI void gla_scan(const Args& a, LAS unsigned char* lds, int b, int h, int seg, float* s_out) {
    const int tid = threadIdx.x, w = __builtin_amdgcn_readfirstlane(tid >> 6), lane = tid & 63, r32 = lane & 31, hh = lane >> 5;
    const bf16_t* Qg = (const bf16_t*)(a.ws + WS_Q); const bf16_t* Kg = (const bf16_t*)(a.ws + WS_K); const bf16_t* VRT = (const bf16_t*)(a.ws + WS_VRT); bf16_t* BR = (bf16_t*)(a.ws + WS_BR);
    float* AGG = (float*)(a.ws + WS_AGG); float* DCUM = (float*)(a.ws + WS_DCUM);
    const int vcol = h * 256 + 32 * w + r32, tok0 = b * 4096 + seg * GLA_SEG_CH * 64, bh = b * 4 + h;
    const bf16_t* vrow = VRT + (size_t)vcol * MTOK; const bf16_t* rrow = VRT + (size_t)(1024 + vcol) * MTOK;
    const float ghead = a.in[17][vcol];
    auto stage = [&](int n) { const int t0 = tok0 + 64 * n; LAS unsigned char* img = lds + (n & 1) * GB_IMG;
        int tl = threadIdx.x; asm volatile("" : "+v"(tl));
        unsigned soQ[2], soA, soD;
#pragma unroll
        for (int i = 0; i < 2; ++i) { const int p = tl + 512 * i, R = p >> 4, q = (p & 15) ^ (R & 15); soQ[i] = (unsigned)(R * 512 + h * 128 + q * 8); }
        { const int p = tl, R = p >> 4, q = (p & 15) ^ (R & 15), t = 2 * R + (q >> 3), j = q & 7; soA = (unsigned)(t * DM + 512 + h * 256 + j * 8); }
        { const int p = tl & 31; soD = (unsigned)((p >> 3) * DM + 512 + h * 256 + 64 + (p & 7) * 8); }
#pragma unroll
        for (int i = 0; i < 2; ++i) {
            if (MODE == 1) __builtin_amdgcn_global_load_lds((const unsigned*)(Qg + (size_t)t0 * 512 + soQ[i]), (LAS unsigned*)(img + (512 * i + 64 * w) * 16), 16, 0, 0);
            __builtin_amdgcn_global_load_lds((const unsigned*)(Kg + (size_t)t0 * 512 + soQ[i]), (LAS unsigned*)(img + GB_KT + (512 * i + 64 * w) * 16), 16, 0, 0); }
        if (MODE == 1) __builtin_amdgcn_global_load_lds((const unsigned*)(BR + (size_t)t0 * DM + soA), (LAS unsigned*)(img + GB_AT + (64 * w) * 16), 16, 0, 0);
        if (w == 0 && lane < 32) __builtin_amdgcn_global_load_lds((const unsigned*)(BR + (size_t)t0 * DM + soD), (LAS unsigned*)(img + GB_DEC), 16, 0, 0); };
    bf16x8 vf[4];
#pragma unroll
    for (int s = 0; s < 4; ++s) vf[s] = *(const bf16x8*)(vrow + tok0 + 16 * s + 8 * hh);
    stage(0);
    f32x16 S[4];
#pragma unroll
    for (int kt = 0; kt < 4; ++kt)
#pragma unroll
        for (int i = 0; i < 16; ++i) S[kt][i] = 0.f;
    if (MODE == 1) {
        for (int j = 0; j < seg; ++j) { const float* ag = AGG + ((size_t)((bh * GLA_NAGG + j) * 8 + w) * 64) * 64 + lane; const float* dc = DCUM + (size_t)(bh * GLA_NAGG + j) * 128;
#pragma unroll
            for (int kt = 0; kt < 4; ++kt)
#pragma unroll
                for (int g = 0; g < 4; ++g) { const f32x4 d = *(const f32x4*)(dc + 32 * kt + 8 * g + 4 * hh);
#pragma unroll
                    for (int e = 0; e < 4; ++e) S[kt][4 * g + e] = S[kt][4 * g + e] * d[e] + ag[(size_t)(kt * 16 + 4 * g + e) * 64]; } }
    }
    float dprod = 1.0f;
    for (int n = 0; n < GLA_SEG_CH; ++n) {
        const int t0 = tok0 + 64 * n; const LAS unsigned char* img = lds + (n & 1) * GB_IMG;
        asm volatile("s_waitcnt vmcnt(0) lgkmcnt(0)" ::: "memory"); __builtin_amdgcn_s_barrier(); asm volatile("" ::: "memory");
        if (n + 1 < GLA_SEG_CH) stage(n + 1);
        bf16x8 vn[4];
        u32x2 rw[8];
        f32x16 op[2];
        if (MODE == 1) {
#pragma unroll
            for (int tt = 0; tt < 2; ++tt) {
                f32x16 c;
#pragma unroll
                for (int i = 0; i < 16; ++i) c[i] = 0.f;
                const int t = 32 * tt + r32;
#pragma unroll
                for (int s = 0; s < 2 * (tt + 1); ++s) { const int R = t >> 1, q = (t & 1) * 8 + 2 * s + hh;
                    const bf16x8 af = *(const LAS bf16x8*)(img + GB_AT + R * 256 + ((q ^ (R & 15)) * 16));
                    c = __builtin_amdgcn_mfma_f32_32x32x16_bf16(af, vf[s], c, 0, 0, 0); }
#pragma unroll
                for (int kt = 0; kt < 4; ++kt)
#pragma unroll
                    for (int s = 0; s < 2; ++s) {
                        u32x4 pw; pw.x = pk_bf16(S[kt][8 * s], S[kt][8 * s + 1]); pw.y = pk_bf16(S[kt][8 * s + 2], S[kt][8 * s + 3]); pw.z = pk_bf16(S[kt][8 * s + 4], S[kt][8 * s + 5]); pw.w = pk_bf16(S[kt][8 * s + 6], S[kt][8 * s + 7]);
                        const bf16x8 sf = __builtin_bit_cast(bf16x8, pw);
                        const int q0 = 4 * kt + 2 * s;
                        const LAS unsigned char* rowp = img + t * 256 + 8 * hh;
                        const s16x4 lo = *(const LAS s16x4*)(rowp + ((q0 ^ (t & 15)) * 16)), hi = *(const LAS s16x4*)(rowp + (((q0 + 1) ^ (t & 15)) * 16));
                        const bf16x8 af = __builtin_shufflevector(lo, hi, 0, 1, 2, 3, 4, 5, 6, 7);
                        c = __builtin_amdgcn_mfma_f32_32x32x16_bf16(af, sf, c, 0, 0, 0);
                        if (s == 1) asm volatile("" ::: "memory");
                    }
                op[tt] = c;
            }
#pragma unroll
            for (int tt = 0; tt < 2; ++tt) {
                float x[16];
#pragma unroll
                for (int i = 0; i < 16; ++i) x[i] = op[tt][i] * op[tt][i];
#pragma unroll
                for (int i = 0; i < 8; ++i) { const bool up = (lane & 16) != 0; const float keep = up ? x[i + 8] : x[i], send = up ? x[i] : x[i + 8]; x[i] = keep + __shfl_xor(send, 16); }
#pragma unroll
                for (int i = 0; i < 4; ++i) { const bool up = (lane & 8) != 0; const float keep = up ? x[i + 4] : x[i], send = up ? x[i] : x[i + 4]; x[i] = keep + __shfl_xor(send, 8); }
#pragma unroll
                for (int i = 0; i < 2; ++i) { const bool up = (lane & 4) != 0; const float keep = up ? x[i + 2] : x[i], send = up ? x[i] : x[i + 2]; x[i] = keep + __shfl_xor(send, 4); }
                { const bool up = (lane & 2) != 0; const float keep = up ? x[1] : x[0], send = up ? x[0] : x[1]; x[0] = keep + __shfl_xor(send, 2); }
                x[0] += __shfl_xor(x[0], 1);
                if ((lane & 1) == 0) { const int reg = (r32 >> 1) & 15; *(LAS float*)(lds + GB_SSQ + (n & 1) * 2048 + (32 * tt + crow(reg, hh)) * 32 + w * 4) = x[0]; }
            }
        } else { if (tid < 128) dprod *= *(const LAS float*)(img + GB_DEC + tid * 4); }
#pragma unroll
        for (int s = 0; s < 4; ++s) vn[s] = (n + 1 < GLA_SEG_CH) ? *(const bf16x8*)(vrow + t0 + 64 + 16 * s + 8 * hh) : vf[s];
        if (MODE == 1) {
#pragma unroll
            for (int i = 0; i < 8; ++i) rw[i] = *(const u32x2*)(rrow + t0 + 32 * (i >> 2) + 8 * (i & 3) + 4 * hh); }
#pragma unroll
        for (int kt = 0; kt < 4; ++kt) {
#pragma unroll
            for (int g = 0; g < 4; ++g) { const f32x4 d = *(const LAS f32x4*)(img + GB_DEC + (32 * kt + 8 * g + 4 * hh) * 4);
#pragma unroll
                for (int e = 0; e < 4; ++e) S[kt][4 * g + e] *= d[e]; }
            const int c = 32 * kt + r32, R = c >> 1;
#pragma unroll
            for (int s = 0; s < 4; ++s) { const int q = (c & 1) * 8 + 2 * s + hh;
                const bf16x8 af = *(const LAS bf16x8*)(img + GB_KT + R * 256 + ((q ^ (R & 15)) * 16));
                S[kt] = __builtin_amdgcn_mfma_f32_32x32x16_bf16(af, vf[s], S[kt], 0, 0, 0); }
            asm volatile("" ::: "memory");
        }
        if (MODE == 1) {
            asm volatile("s_waitcnt lgkmcnt(0)" ::: "memory"); __builtin_amdgcn_s_barrier(); asm volatile("" ::: "memory");
            LAS unsigned char* ost = lds + GB_OST + w * 4096; const LAS unsigned char* sq = lds + GB_SSQ + (n & 1) * 2048; LAS unsigned char* rsw = lds + GB_RST + w * 256;
            { const LAS f32x4* sp = (const LAS f32x4*)(sq + lane * 32); const f32x4 s0 = sp[0], s1 = sp[1];
              const float ss = ((s0[0] + s0[1]) + (s0[2] + s0[3])) + ((s1[0] + s1[1]) + (s1[2] + s1[3]));
              *(LAS float*)(rsw + lane * 4) = 1.0f / sqrtf(ss * (1.0f / 256.0f) + EPS); }
            LDS_WAIT();
#pragma unroll
            for (int tt = 0; tt < 2; ++tt)
#pragma unroll
                for (int g4 = 0; g4 < 4; ++g4) {
                    const int tb = 32 * tt + 8 * g4 + 4 * hh; const u32x2 r2 = rw[tt * 4 + g4];
                    const float rv[4] = {bf_lo(r2.x), bf_hi(r2.x), bf_lo(r2.y), bf_hi(r2.y)};
                    const f32x4 rs4 = *(const LAS f32x4*)(rsw + tb * 4);
#pragma unroll
                    for (int e = 0; e < 4; ++e) { const float val = op[tt][4 * g4 + e] * rs4[e] * ghead * rv[e];
                        *(LAS bf16_t*)(ost + (tb + e) * 64 + r32 * 2) = (bf16_t)(pk_bf16(val, 0.f) & 0xffffu); }
                }
            LDS_WAIT();
#pragma unroll
            for (int i = 0; i < 4; ++i) { const int x = lane + 64 * i, t = x >> 2, part = x & 3; const u32x4 v = *(const LAS u32x4*)(ost + t * 64 + part * 16);
                *(u32x4*)(BR + (size_t)(t0 + t) * DM + 512 + h * 256 + 32 * w + part * 8) = v; }
        }
#pragma unroll
        for (int s = 0; s < 4; ++s) vf[s] = vn[s];
    }
    if (MODE == 1) {
        if (seg == GLA_SEGS - 1) {
#pragma unroll
            for (int kt = 0; kt < 4; ++kt)
#pragma unroll
                for (int i = 0; i < 16; ++i) s_out[(size_t)(32 * kt + crow(i, hh)) * 256 + 32 * w + r32] = S[kt][i]; }
    } else {
        float* ag = AGG + ((size_t)((bh * GLA_NAGG + seg) * 8 + w) * 64) * 64 + lane;
#pragma unroll
        for (int kt = 0; kt < 4; ++kt)
#pragma unroll
            for (int i = 0; i < 16; ++i) ag[(size_t)(kt * 16 + i) * 64] = S[kt][i];
        if (tid < 128) DCUM[(size_t)(bh * GLA_NAGG + seg) * 128 + tid] = dprod;
    }
}

DI void p5_rows(const Args& a, int gw, int NGW, int lane) {
    const bf16_t* Y2 = (const bf16_t*)(a.ws + WS_Y2); const float* SQ = (const float*)(a.ws + WS_SSQ); bf16_t* H2 = (bf16_t*)(a.ws + WS_H2);
    f32x4 ax[8], bx_[8]; u32x2 ay[8], by[8]; float aq = 0.f, bq = 0.f;
    auto issueA = [&](int m) { const float* xr = (m < NPROMPT) ? a.in[0] + (size_t)m * DM : a.in[1] + (size_t)(m - NPROMPT) * DM; const bf16_t* yr = Y2 + (size_t)m * DM;
#pragma unroll
        for (int j = 0; j < 8; ++j) { ax[j] = ((const f32x4*)xr)[lane + 64 * j]; ay[j] = ((const u32x2*)yr)[lane + 64 * j]; }
        aq = (lane < 32) ? SQ[(size_t)m * 32 + lane] : 0.f; };
    auto issueB = [&](int m) { const float* xr = (m < NPROMPT) ? a.in[0] + (size_t)m * DM : a.in[1] + (size_t)(m - NPROMPT) * DM; const bf16_t* yr = Y2 + (size_t)m * DM;
#pragma unroll
        for (int j = 0; j < 8; ++j) { bx_[j] = ((const f32x4*)xr)[lane + 64 * j]; by[j] = ((const u32x2*)yr)[lane + 64 * j]; }
        bq = (lane < 32) ? SQ[(size_t)m * 32 + lane] : 0.f; };
    auto sample_row = [&](int m, f32x4 (&yv)[8]) -> float { const float* pr = (const float*)(a.ws + WS_PART) + (size_t)(m - NPROMPT) * DM; float q = 0.f;
#pragma unroll
        for (int j = 0; j < 8; ++j) { f32x4 t = ((const f32x4*)pr)[lane + 64 * j];
#pragma unroll
            for (int k = 1; k < 4; ++k) t += ((const f32x4*)(pr + (size_t)k * 1024 * DM))[lane + 64 * j];
            yv[j] = t; q += (t.x * t.x + t.y * t.y) + (t.z * t.z + t.w * t.w); }
        return q; };
    auto row = [&](int m, f32x4 (&xv)[8], f32x4 (&yv)[8], float q) {
        if (m >= NPROMPT) q = sample_row(m, yv);
        float* orow = a.out + O_Y + (size_t)m * DM; bf16_t* hr = H2 + (size_t)m * DM;
        const float rstd = 1.0f / sqrtf(wave_sum(q) * (1.f / DM) + EPS);
        float s2 = 0.f;
#pragma unroll
        for (int j = 0; j < 8; ++j) { const f32x4 gg = ((const f32x4*)a.in[24])[lane + 64 * j]; f32x4 t;
            t.x = xv[j].x + yv[j].x * rstd * gg.x; t.y = xv[j].y + yv[j].y * rstd * gg.y; t.z = xv[j].z + yv[j].z * rstd * gg.z; t.w = xv[j].w + yv[j].w * rstd * gg.w;
            xv[j] = t; ((f32x4*)orow)[lane + 64 * j] = t; s2 += (t.x * t.x + t.y * t.y) + (t.z * t.z + t.w * t.w); }
        const float rstd2 = 1.0f / sqrtf(wave_sum(s2) * (1.f / DM) + EPS);
#pragma unroll
        for (int j = 0; j < 8; ++j) { const f32x4 gg = ((const f32x4*)a.in[25])[lane + 64 * j]; u32x2 w; w.x = pk_bf16(xv[j].x * rstd2 * gg.x, xv[j].y * rstd2 * gg.y); w.y = pk_bf16(xv[j].z * rstd2 * gg.z, xv[j].w * rstd2 * gg.w);
            ((u32x2*)hr)[lane + 64 * j] = w; } };
    int m = gw;
    if (m < MTOK) issueA(m);
    if (m + NGW < MTOK) issueB(m + NGW);
    for (; m < MTOK; m += 2 * NGW) {
        { f32x4 xv[8], yv[8]; const float q = aq;
#pragma unroll
          for (int j = 0; j < 8; ++j) { xv[j] = ax[j]; yv[j] = (f32x4){bf_lo(ay[j].x), bf_hi(ay[j].x), bf_lo(ay[j].y), bf_hi(ay[j].y)}; }
          if (m + 2 * NGW < MTOK) issueA(m + 2 * NGW);
          row(m, xv, yv, q); }
        if (m + NGW < MTOK) { f32x4 xv[8], yv[8]; const float q = bq;
#pragma unroll
          for (int j = 0; j < 8; ++j) { xv[j] = bx_[j]; yv[j] = (f32x4){bf_lo(by[j].x), bf_hi(by[j].x), bf_lo(by[j].y), bf_hi(by[j].y)}; }
          if (m + 3 * NGW < MTOK) issueB(m + 3 * NGW);
          row(m + NGW, xv, yv, q); }
    }
}
DI void p9_rows(const Args& a, int gw, int NGW, int lane) {
    const bf16_t* Fb = (const bf16_t*)(a.ws + WS_F); const float* SQ = (const float*)(a.ws + WS_SSQ2);
    f32x4 nx[8]; u32x2 ny[8]; float nq = 0.f;
    auto issue = [&](int m) { const float* xr = a.out + O_Y + (size_t)m * DM; const bf16_t* yr = Fb + (size_t)m * DM;
#pragma unroll
        for (int j = 0; j < 8; ++j) { nx[j] = ((const f32x4*)xr)[lane + 64 * j]; ny[j] = ((const u32x2*)yr)[lane + 64 * j]; }
        nq = (lane < 32) ? SQ[(size_t)m * 32 + lane] : 0.f; };
    auto sample_row = [&](int m, f32x4 (&yv)[8]) -> float { const float* pr = (const float*)(a.ws + WS_PART2) + (size_t)(m - NPROMPT) * DM; float q = 0.f;
#pragma unroll
        for (int j = 0; j < 8; ++j) { f32x4 t = ((const f32x4*)pr)[lane + 64 * j];
#pragma unroll
            for (int k = 1; k < 2; ++k) t += ((const f32x4*)(pr + (size_t)k * 1024 * DM))[lane + 64 * j];
            yv[j] = t; q += (t.x * t.x + t.y * t.y) + (t.z * t.z + t.w * t.w); }
        return q; };
    int m = gw; if (m < MTOK) issue(m);
    for (; m < MTOK; m += NGW) {
        f32x4 xv[8]; f32x4 yv[8]; float q = nq;
#pragma unroll
        for (int j = 0; j < 8; ++j) { xv[j] = nx[j]; yv[j] = (f32x4){bf_lo(ny[j].x), bf_hi(ny[j].x), bf_lo(ny[j].y), bf_hi(ny[j].y)}; }
        if (m >= NPROMPT) q = sample_row(m, yv);
        if (m + NGW < MTOK) issue(m + NGW);
        float* orow = a.out + O_Y + (size_t)m * DM;
        const float rstd = 1.0f / sqrtf(wave_sum(q) * (1.f / DM) + EPS);
#pragma unroll
        for (int j = 0; j < 8; ++j) { const f32x4 gg = ((const f32x4*)a.in[30])[lane + 64 * j]; f32x4 t;
            t.x = xv[j].x + yv[j].x * rstd * gg.x; t.y = xv[j].y + yv[j].y * rstd * gg.y; t.z = xv[j].z + yv[j].z * rstd * gg.z; t.w = xv[j].w + yv[j].w * rstd * gg.w;
            ((f32x4*)orow)[lane + 64 * j] = t; }
    }
}
DI float gelu_tanh(float x) { const float z = 1.5957691216057308f * (x + 0.044715f * x * x * x); return x * __builtin_amdgcn_rcpf(1.0f + __expf(-z)); }
DI void seam_rows(const Args& a, int pm) {
    const float* HEAD = (const float*)(a.ws + WS_HEAD) + (size_t)pm * 2 * F2; const float* TAIL = (const float*)(a.ws + WS_TAIL) + (size_t)(pm - 1) * 2 * F2;
    const float* wdw = a.in[27]; const float* bdw = a.in[28]; bf16_t* HG = (bf16_t*)(a.ws + WS_HG) + (size_t)pm * 256 * FF;
    for (int i = threadIdx.x; i < 2 * FF; i += 512) { const int r = i / FF, f = i - r * FF;
        float cg = bdw[f], cv = bdw[FF + f];
        const float* a0 = HEAD + (size_t)r * F2; const float* a1 = r ? HEAD : TAIL + F2; const float* a2 = r ? TAIL + F2 : TAIL;
        cg += wdw[f] * a2[f] + wdw[F2 + f] * a1[f] + wdw[2 * F2 + f] * a0[f];
        cv += wdw[FF + f] * a2[FF + f] + wdw[F2 + FF + f] * a1[FF + f] + wdw[2 * F2 + FF + f] * a0[FF + f];
        HG[(size_t)r * FF + f] = (bf16_t)(pk_bf16(gelu_tanh(cg) * cv, 0.f) & 0xffffu); }
}

constexpr int WCOPY_WO = 2048, WCOPY_UP = WCOPY_WO + 32 * 352, WCOPY_N = WCOPY_UP + 88 * 64, WCOPY_T1 = 3456;
DI void wcopy_items(const Args& a, LAS unsigned char* lds, int i0, int i1, int g, int NG, int wave, int lane) {
    LAS float* scr = (LAS float*)(lds + wave * 16384);
    const float* w_o = as_global(a.in[23]); const float* w_up = as_global(a.in[26]); const float* w_dn = as_global(a.in[29]); unsigned char* ws = as_global(a.ws);
    tr_pipeline([=](int it) -> TrSrc { TrSrc t;
        if (it < WCOPY_WO) { const int kb = it / 64, n0 = (it % 64) * 32; t.src = w_o + (size_t)(kb * 64) * 2048 + n0; t.ldw = 2048; t.dst = (bf16_t*)(ws + WS_WO) + (size_t)n0 * DM + kb * 64; t.dld = DM; }
        else if (it < WCOPY_UP) { const int r = it - WCOPY_WO, kb = r / 352, n0 = (r % 352) * 32; const int part = n0 / FF, jf = n0 % FF, rho = (jf >> 7) * 256 + part * 128 + (jf & 127);
            t.src = w_up + (size_t)(kb * 64) * F2 + n0; t.ldw = F2; t.dst = (bf16_t*)(ws + WS_WUP) + (size_t)rho * DM + kb * 64; t.dld = DM; }
        else { const int r = it - WCOPY_UP, kb = r / 64, n0 = (r % 64) * 32; t.src = w_dn + (size_t)(kb * 64) * 2048 + n0; t.ldw = 2048; t.dst = (bf16_t*)(ws + WS_WDN) + (size_t)n0 * FF + kb * 64; t.dld = FF; }
        return t; }, i0, i1, g, NG, scr, lane);
}

constexpr int PH_P0 = 0, PH_P1 = 1, PH_P2A = 2, PH_P2B = 3, PH_P2C = 4, PH_MERGE = 5, PH_WO = 6, PH_NORM1 = 7, PH_UP = 8, PH_DOWN = 9, PH_FINAL = 10, NPH = 11;
__global__ void __launch_bounds__(512, 2) fwd_kernel(Args args_unused) {
    extern __shared__ __attribute__((aligned(16))) unsigned char lds_raw[];
    LAS unsigned char* lds = (LAS unsigned char*)lds_raw;
    { const unsigned* kp = (const unsigned*)__builtin_amdgcn_kernarg_segment_ptr(); if (threadIdx.x < ARGS_DW) ((LAS unsigned*)(lds + LDSARGS_OFF))[threadIdx.x] = kp[threadIdx.x]; }
    volatile LAS unsigned* MISC = (volatile LAS unsigned*)(lds + MISC_OFF);
    const int tid = threadIdx.x, lane = tid & 63, wave = __builtin_amdgcn_readfirstlane(tid >> 6);
    const int G = gridDim.x, bx = blockIdx.x, vcu = (G % 8 == 0) ? (bx % 8) * (G / 8) + bx / 8 : bx;
    const int gw = vcu * 8 + wave, NGW = G * 8;
    for (int u = tid; u < (MISC_OFF + 128 - LDSCTL_OFF) / 4; u += 512) ((LAS unsigned*)(lds + LDSCTL_OFF))[u] = 0u;
    __syncthreads();
    int lo, hi, li; unsigned char* ws0;
    { const Args a0 = fetch_args(lds); lo = a0.ph_lo; hi = a0.ph_hi; li = a0.li; ws0 = a0.ws; }
    const bool multi = (hi - lo) > 1;
    XcdBarrier bar; bar.bar = (unsigned*)(ws0 + WS_CTL) + CW_BAR + li * XCD_BAR_WORDS; bar.x = 0; bar.st = nullptr;
    if (multi) bar = xcd_barrier_post((unsigned*)(ws0 + WS_CTL) + CW_BAR + li * XCD_BAR_WORDS, MISC + 8);
#define IN(k) (lo <= (k) && (k) < hi)
#define SEAM(k) do { if (IN(k) && IN((k) + 1)) xcd_barrier(bar); } while (0)

    if (IN(PH_P0)) { const Args args = fetch_args<((GMASK >> PH_P0) & 1) != 0>(lds); p0_prologue(args, lds, gw, NGW, wave, lane); }
    SEAM(PH_P0);
    if (IN(PH_P1)) {
        const Args args = fetch_args<((GMASK >> PH_P1) & 1) != 0>(lds); unsigned char* ws = args.ws; bf16_t* RB = (bf16_t*)(ws + WS_RB);
        pg8::Gemm g{RB, RB, DM, DM, DM}; pg8::SchedP1 S{G, bx};
        pg8::EpiP1 E{ws, args.out, args.in[19]};
        pg8::gemm_phase<pg8::EpiP1, pg8::SchedP1>(lds, g, S, E);
    }
    SEAM(PH_P1);
    if (IN(PH_P2A)) {
        const Args args = fetch_args<((GMASK >> PH_P2A) & 1) != 0>(lds); const int h = bx & 3;
        for (int i = tid; i < 16 * 128; i += 512) *(LAS float*)(lds + GL_WG + i * 4) = args.in[15][(size_t)(i >> 7) * 512 + h * 128 + (i & 127)];
        for (int bn = (bx >> 2); bn < 256; bn += (G >> 2)) { gla_prep_chunk(args, lds, (bn >> 6) * 4096 + (bn & 63) * 64, h); }
        constexpr int N_MA = 2048, N_PL = MTOK / 8;
        for (int it = gw; it < N_MA + N_PL; it += NGW) { if (it < N_MA) mem_attn_item(args, it, lane); else pool_item(args, it - N_MA, lane); }
    }
    SEAM(PH_P2A);
    if (IN(PH_P2B)) {
        const Args args = fetch_args<((GMASK >> PH_P2B) & 1) != 0>(lds);
        if (bx < 16 * GLA_NAGG) { gla_scan<0>(args, lds, (bx >> 2) & 3, bx & 3, bx >> 4, nullptr); }
        else {
            if (bx < 240) { const int it = bx - 112; gla_sequence<32>(args, lds, NPROMPT + (it >> 2) * 32, 1, it & 3, args.in[4] + (size_t)it * 128 * 256, args.out + O_GLAS + (size_t)it * 128 * 256); __syncthreads(); }
            if (bx >= 240) { const int it = (bx - 240) * 8 + wave; if (it < 128) mem_attn_item(args, 2048 + it, lane); }
            wcopy_items(args, lds, 0, WCOPY_T1, (bx - 112) * 8 + wave, (G - 112) * 8, wave, lane);
        }
    }
    SEAM(PH_P2B);
    if (IN(PH_P2C)) {
        const Args args = fetch_args<((GMASK >> PH_P2C) & 1) != 0>(lds); unsigned char* ws = args.ws;
        if (bx < 16 * GLA_SEGS) { const int bh = bx & 15; gla_scan<1>(args, lds, bh >> 2, bh & 3, bx >> 4, args.out + O_GLAP + (size_t)bh * 128 * 256); }
        else if (bx < 160) {
            pg8::Gemm g{(const bf16_t*)(ws + WS_BR), (const bf16_t*)(ws + WS_WB), DM, DM, DM}; pg8::SchedOne S{64 + ((bx - 128) >> 3), (bx - 128) & 7, 32};
            pg8::EpiMerge E{ws};
            pg8::gemm_phase<pg8::EpiMerge, pg8::SchedOne>(lds, g, S, E);
        }
        else wcopy_items(args, lds, WCOPY_T1, WCOPY_N, (bx - 160) * 8 + wave, (G - 160) * 8, wave, lane);
    }
    SEAM(PH_P2C);
    if (IN(PH_MERGE)) {
        const Args args = fetch_args<((GMASK >> PH_MERGE) & 1) != 0>(lds); unsigned char* ws = args.ws;
        pg8::Gemm g{(const bf16_t*)(ws + WS_BR), (const bf16_t*)(ws + WS_WB), DM, DM, DM}; pg8::Sched2D S{64, 8, G, bx, 0, 0, 32};
        pg8::EpiMerge E{ws};
        pg8::gemm_phase<pg8::EpiMerge, pg8::Sched2D>(lds, g, S, E);
    }
    SEAM(PH_MERGE);
    if (IN(PH_WO)) {
        const Args args = fetch_args<((GMASK >> PH_WO) & 1) != 0>(lds); unsigned char* ws = args.ws;
        pg8::Gemm g{(const bf16_t*)(ws + WS_MG), (const bf16_t*)(ws + WS_WO), DM, DM, DM}; pg8::SchedTail S{G, bx, 32, 128};
        pg8::EpiNorm E{(bf16_t*)(ws + WS_Y2), (float*)(ws + WS_SSQ), (float*)(ws + WS_PART)};
        pg8::gemm_phase<pg8::EpiNorm, pg8::SchedTail>(lds, g, S, E);
    }
    SEAM(PH_WO);
    if (IN(PH_NORM1)) {
        const Args args = fetch_args<((GMASK >> PH_NORM1) & 1) != 0>(lds); unsigned char* ws = args.ws;
        p5_rows(args, gw, NGW, lane);
    }
    SEAM(PH_NORM1);
    if (IN(PH_UP)) {
        const Args args = fetch_args<((GMASK >> PH_UP) & 1) != 0>(lds); unsigned char* ws = args.ws;
        pg8::Gemm g{(const bf16_t*)(ws + WS_H2), (const bf16_t*)(ws + WS_WUP), DM, DM, DM}; pg8::SchedUp S{G, bx};
        pg8::EpiUpConv E{ws, args.out, args.in[27], args.in[28], args.in[5], lds};
        pg8::gemm_phase<pg8::EpiUpConv, pg8::SchedUp>(lds, g, S, E);
        if (G - 1 - bx < 64) {
            if (tid == 0) { unsigned* cnt = (unsigned*)(ws + WS_CTL) + CW_UPDONE; unsigned* bw = (unsigned*)(ws + WS_CTL) + CW_BAR;
                for (int p = 0; p < 4; ++p) XB_SPIN(xb_ld(cnt + p * 32) < 44u, bw);
                __builtin_amdgcn_fence(__ATOMIC_ACQUIRE, "agent"); }
            __syncthreads();
            pg8::Gemm g2{(const bf16_t*)(ws + WS_HG), (const bf16_t*)(ws + WS_WDN), FF, FF, FF}; pg8::SchedPieces S2{G, bx};
            pg8::EpiNorm E2{(bf16_t*)(ws + WS_F), (float*)(ws + WS_SSQ2), (float*)(ws + WS_PART2)};
            pg8::gemm_phase<pg8::EpiNorm, pg8::SchedPieces>(lds, g2, S2, E2);
        }
    }
    SEAM(PH_UP);
    if (IN(PH_DOWN)) {
        const Args args = fetch_args<((GMASK >> PH_DOWN) & 1) != 0>(lds); unsigned char* ws = args.ws;
        pg8::SchedTail S{G, bx, 88, 0};
        { pg8::Unit u; for (int i = 0; S.next(i, u); ++i) if (u.om < 64 && (u.om & 15) != 0) seam_rows(args, u.om); }
        asm volatile("s_waitcnt vmcnt(0)" ::: "memory"); __syncthreads();
        pg8::Gemm g{(const bf16_t*)(ws + WS_HG), (const bf16_t*)(ws + WS_WDN), FF, FF, FF};
        pg8::EpiNorm E{(bf16_t*)(ws + WS_F), (float*)(ws + WS_SSQ2), (float*)(ws + WS_PART2)};
        pg8::gemm_phase<pg8::EpiNorm, pg8::SchedTail>(lds, g, S, E);
    }
    SEAM(PH_DOWN);
    if (IN(PH_FINAL)) { const Args args = fetch_args<((GMASK >> PH_FINAL) & 1) != 0>(lds); p9_rows(args, gw, NGW, lane); }
#undef IN
#undef SEAM
}

#ifndef MK_PER_PHASE
#define MK_PER_PHASE 0
#endif
extern "C" void kernel_launch(void* const* d_in, const int* in_sizes, int n_in, void* d_out, int out_size, void* d_ws, size_t ws_size, hipStream_t stream) {
    static int grid = 0;
    if (grid == 0) {
        if (n_in != 31 || in_sizes[0] != NPROMPT * DM || out_size != (int)O_TOTAL || ws_size < WS_END) {
            fprintf(stderr, "kernel_launch: unexpected shapes: n_in %d in0 %d out %d ws %zu (need %zu)\n", n_in, n_in > 0 ? in_sizes[0] : -1, out_size, ws_size, (size_t)WS_END); grid = -1; return; }
        int dev = 0, cus = 0;
        if (hipGetDevice(&dev) != hipSuccess || hipDeviceGetAttribute(&cus, hipDeviceAttributeMultiprocessorCount, dev) != hipSuccess) { grid = -1; return; }
        if (hipFuncSetAttribute((const void*)fwd_kernel, hipFuncAttributeMaxDynamicSharedMemorySize, LDS_BYTES) != hipSuccess) { fprintf(stderr, "kernel_launch: hipFuncSetAttribute failed\n"); grid = -1; return; }
        int per_cu = 0;
        if (hipOccupancyMaxActiveBlocksPerMultiprocessor(&per_cu, (const void*)fwd_kernel, 512, LDS_BYTES) != hipSuccess || per_cu < 1) fprintf(stderr, "kernel_launch: occupancy query reports %d\n", per_cu);
        (void)hipGetLastError();
        grid = cus;
    }
    if (grid < 0) return;
    if (hipMemsetAsync((char*)d_ws + WS_CTL, 0, CTL_ZERO_BYTES, stream) != hipSuccess) return;
    Args a{};
    for (int i = 0; i < 31; ++i) a.in[i] = (const float*)d_in[i];
    a.out = (float*)d_out; a.ws = (unsigned char*)d_ws;
#if MK_PER_PHASE
    for (int p = 0; p < NPH; ++p) { a.ph_lo = p; a.ph_hi = p + 1; a.li = 0; hipLaunchKernelGGL(fwd_kernel, dim3(grid), dim3(512), LDS_BYTES, stream, a); }
#else
    a.ph_lo = 0; a.ph_hi = NPH; a.li = 0;
    hipLaunchKernelGGL(fwd_kernel, dim3(grid), dim3(512), LDS_BYTES, stream, a);
#endif
}
```

```cpp
#include <hip/hip_runtime.h>
#include <cstdio>
#include <cstddef>

#define LAS __attribute__((address_space(3)))
#define GAS __attribute__((address_space(1)))
typedef unsigned short bf16_t;
typedef short bf16x8 __attribute__((ext_vector_type(8)));
typedef short s16x4 __attribute__((ext_vector_type(4)));
typedef float f32x4 __attribute__((ext_vector_type(4)));
typedef float f32x2 __attribute__((ext_vector_type(2)));
typedef float f32x16 __attribute__((ext_vector_type(16)));
typedef unsigned u32x4 __attribute__((ext_vector_type(4)));
typedef unsigned u32x2 __attribute__((ext_vector_type(2)));
typedef __bf16 bf16x2_t __attribute__((ext_vector_type(2)));
typedef GAS unsigned gu32;
#define RLX_AGENT __ATOMIC_RELAXED, __HIP_MEMORY_SCOPE_AGENT
#define DI __device__ __forceinline__

DI unsigned pk_bf16(float lo, float hi) { f32x2 v = {lo, hi}; bf16x2_t b = __builtin_convertvector(v, bf16x2_t); return __builtin_bit_cast(unsigned, b); }
DI float bf_lo(unsigned w) { return __uint_as_float(w << 16); }
DI float bf_hi(unsigned w) { return __uint_as_float(w & 0xffff0000u); }
DI float bf2f(bf16_t b) { return __uint_as_float(((unsigned)b) << 16); }
DI u32x4 pack8(f32x4 a, f32x4 b) { u32x4 w; w.x = pk_bf16(a[0], a[1]); w.y = pk_bf16(a[2], a[3]); w.z = pk_bf16(b[0], b[1]); w.w = pk_bf16(b[2], b[3]); return w; }
DI float fsigmoid(float x) { return __builtin_amdgcn_rcpf(1.0f + __expf(-x)); }

constexpr int DM = 2048, NPROMPT = 4 * 4096, NSAMPLE = 32 * 32, MTOK = NPROMPT + NSAMPLE;
constexpr int NMEMROWS = 4 * 256;
constexpr int INW = 4112, FF = 5632, F2 = 11264, FH = 2816;
constexpr float EPS = 1e-6f;
constexpr float MQ_SCALE = 0.08838834764831845f * 1.4426950408889634f;

constexpr int PN_XN = 0, PN_MN = 68, PN_W = 72;
constexpr int WP_U = 0, WP_Q = 2, WP_K = 4, WP_MQ = 6, WP_ALR = 8, WP_G = 9, WP_V = 33, WP_R = 37, WP_MK = 41, WP_MV = 43, WP_END = 45;
constexpr int RB_ROWS = (PN_W + WP_END) * 256;

constexpr size_t MiB = 1u << 20;
constexpr size_t WS_CTL = 0, CTL_ZERO_BYTES = 32768;
constexpr size_t WS_RB = 1 * MiB;
constexpr size_t WS_WUP = 1 * MiB;
constexpr size_t WS_BR = 45 * MiB;
constexpr size_t WS_WDN = 203 * MiB;
constexpr size_t WS_H2 = 67 * MiB;
constexpr size_t WS_WB = 118 * MiB;
constexpr size_t WS_U = 126 * MiB;
constexpr size_t WS_Q = 160 * MiB, WS_K = 177 * MiB, WS_MQ = 194 * MiB;
constexpr size_t WS_ALR = 211 * MiB;
constexpr size_t WS_KM = 213 * MiB, WS_VMT = 214 * MiB, WS_KS = 215 * MiB, WS_VST = 223 * MiB;
constexpr size_t WS_VRT = 231 * MiB;
constexpr size_t WS_G = 299 * MiB;
constexpr size_t WS_WO = 503 * MiB;
constexpr size_t WS_MG = 135 * MiB;
constexpr size_t WS_Y2 = 231 * MiB;
constexpr size_t WS_SSQ = 225 * MiB;
constexpr size_t WS_SCR = 135 * MiB;
constexpr size_t WS_HEAD = 231 * MiB, WS_TAIL = 238 * MiB;
constexpr size_t WS_HG = 322 * MiB;
constexpr size_t WS_F = 135 * MiB;
constexpr size_t WS_SSQ2 = 228 * MiB;
constexpr size_t WS_AGG = 126 * MiB, WS_DCUM = 141 * MiB;
constexpr size_t WS_PART = 299 * MiB;
constexpr size_t WS_PART2 = 246 * MiB;
constexpr size_t WS_END = 512 * MiB;
static_assert(WS_RB + (size_t)RB_ROWS * DM * 2 <= WS_WB, "RB");
static_assert(WS_HG + (size_t)MTOK * FF * 2 <= 511 * MiB, "HG");
static_assert(WS_G + (size_t)MTOK * 6144 * 2 <= WS_WO, "G");
static_assert(WS_VRT + (size_t)2048 * MTOK * 2 <= WS_G, "VRT");

constexpr size_t O_Y = 0, O_POOLP = 35651584, O_POOLS = 35682304, O_GLAP = 35928064, O_GLAS = 36452352, O_CONVP = 40646656, O_CONVS = 40736768, O_MEMK = 41457664, O_MEMV = 41981952, O_TOTAL = 42506240;

constexpr int CW_BAR = 4096;
constexpr int CW_UPDONE = 64;

constexpr int RING_BYTES = 131072, LDSCTL_OFF = RING_BYTES, MISC_OFF = LDSCTL_OFF + 320, LDS_BYTES = 131072 + 1024 + 16384 + 2048;

namespace pg8 {
constexpr int BM = 256, BK = 64, HALF = 128, HTB = HALF * BK * 2, STAGE_BYTES = 8 * HTB;
DI int lds_byte(int r, int c) { const int st = (r >> 4) * 2 + (c >> 5), rr = r & 15, cc = c & 31, ob = rr * 64 + cc * 2; return st * 1024 + (ob ^ (((ob >> 9) & 1) << 5)); }
DI void stage_rc(int b, int& R, int& C) { const int st = b / 1024, sb = b % 1024, swz = sb ^ (((sb >> 9) & 1) << 5); R = (st >> 1) * 16 + swz / 64; C = (st & 1) * 32 + (swz % 64) / 2; }
DI int perm32(int rho) { const int n = rho >> 4, i = rho & 15; return 8 * (i >> 2) + 4 * n + (i & 3); }

struct Unit { int arow, brow, kind, om, on, koff, nt, seq; };
struct Gemm { const bf16_t* A; const bf16_t* B; int lda, ldb, K; };

#ifndef P1_CHIPWIDE
#define P1_CHIPWIDE 1
#endif
#ifndef GEMM_WGM
#define GEMM_WGM 4
#endif
DI void grid_map(int wgid, int nM, int nN, int& pm, int& pn, int wgm = 8) {
    const int nwg = nM * nN; { const int q = nwg / 8, r = nwg % 8, xcd = wgid % 8, off = wgid / 8; wgid = (xcd < r ? xcd * (q + 1) : r * (q + 1) + (xcd - r) * q) + off; }
    const int nig = wgm * nN, gid = wgid / nig, fm = gid * wgm, gsz = (nM - fm) < wgm ? (nM - fm) : wgm;
    pm = fm + ((wgid % nig) % gsz); pn = (wgid % nig) / gsz;
    if (nN == 8 && gsz == 8) { pm = fm + (wgid % nig) / 8; pn = (wgid % nig) % 8; }
}
struct Sched2D {
    int nM, nN, G, c, a0, b0, ntK;
    DI bool next(int i, Unit& u) const { const long L = (long)i * G + c; if (L >= (long)nM * nN) return false; int pm, pn; grid_map((int)L, nM, nN, pm, pn);
        u.arow = (a0 + pm) * 256; u.brow = (b0 + pn) * 256; u.kind = 0; u.om = pm; u.on = pn; u.koff = 0; u.nt = ntK; return true; }
};
struct SchedTail {
    int G, c, ntK, np;
    DI bool next(int i, Unit& u) const { const long L = (long)i * G + c; if (L >= 512 + np) return false;
        int pm = 0, pn = 0; grid_map(L < 512 ? (int)L : 0, 64, 8, pm, pn);
        const int x = (int)L - 512, t = x >> 2, kq = x & 3; const bool full = L < 512;
        const int om = full ? pm : 64 + (t >> 3), on = full ? pn : (t & 7);
        Unit r; r.seq = 0; r.arow = om * 256; r.brow = on * 256; r.kind = full ? 0 : 1 + kq; r.om = om; r.on = on; r.koff = full ? 0 : kq * (ntK / 4) * 64; r.nt = full ? ntK : ntK / 4;
        u = r; return true; }
};
struct SchedOne { int pm, pn, ntK;
    DI bool next(int i, Unit& u) const { if (i > 0) return false; Unit r; r.arow = pm * 256; r.brow = pn * 256; r.kind = 0; r.om = pm; r.on = pn; r.koff = 0; r.nt = ntK; r.seq = 0; u = r; return true; } };
struct SchedUp { int G, c;
    DI bool next(int i, Unit& u) const { const long L = (long)i * G + c; if (L >= 68 * 44) return false; int pm, pn;
        if (L < 176) { const int x = (int)L & 7, t = (int)L >> 3; pm = 64 + (x & 3); pn = 2 * t + (x >> 2); }
        else grid_map((int)L - 176, 64, 44, pm, pn, GEMM_WGM);
        Unit r; r.arow = pm * 256; r.brow = pn * 256; r.kind = 0; r.om = pm; r.on = pn; r.koff = 0; r.nt = 32; r.seq = 0; u = r; return true; } };
struct SchedPieces { int G, c;
    DI bool next(int i, Unit& u) const { const int j = (G - 1 - c) + i * G; if (j >= 64) return false; const int t = j >> 1, kq = j & 1;
        Unit r; r.om = 64 + (t >> 3); r.on = t & 7; r.arow = r.om * 256; r.brow = r.on * 256; r.kind = 1 + kq; r.koff = kq * 44 * 64; r.nt = 44; r.seq = 0; u = r; return true; } };
struct SchedP1 {
    int G, c;
    static constexpr int N0 = 68 * 33, N1 = 8 * 68, N2 = 24;
    DI bool next(int i, Unit& u) const { long L = (long)i * G + c; if (L >= N0 + N1 + N2) return false; int pm, pn; u.koff = 0; u.nt = 32;
        if (L < N0) {
            if (P1_CHIPWIDE) { const int l = (int)L;
                if (l < 68 * 32) { const int x = l & 7, k = (l >> 3) & 31, sg = l >> 8; if (sg < 8) { pm = 8 * sg + (k & 7); pn = 4 * x + (k >> 3); } else { pm = 64 + (k & 3); pn = 4 * x + (k >> 2); } }
                else { pm = l - 68 * 32; pn = 32; } }
            else grid_map((int)L, 68, 33, pm, pn, GEMM_WGM); u.arow = (PN_XN + pm) * 256; u.brow = (PN_W + pn) * 256; u.kind = 0; u.om = pm; u.on = pn; return true; }
        L -= N0;
        if (L < N1) { grid_map((int)L, 8, 68, pm, pn); u.arow = (PN_W + WP_V + pm) * 256; u.brow = (PN_XN + pn) * 256; u.kind = 1; u.om = pm; u.on = pn; return true; }
        L -= N1; const int j = (int)L & 7, t = (int)L >> 3;
        if (t == 0) { u.om = j >> 1; u.on = j & 1; u.arow = (PN_MN + u.om) * 256; u.brow = (PN_W + WP_MK + u.on) * 256; u.kind = 2; }
        else if (t == 1) { u.om = j >> 1; u.on = j & 1; u.arow = (PN_MN + u.om) * 256; u.brow = (PN_W + WP_MV + u.on) * 256; u.kind = 3; }
        else { u.om = j >> 2; u.on = j & 3; u.arow = (PN_W + WP_MV + u.om) * 256; u.brow = (PN_MN + u.on) * 256; u.kind = 4; }
        return true; }
};

DI u32x4 quad16(u32x4 w, int lane) { const int src = (((lane >> 2) + 16 * (lane & 3)) << 2); u32x4 r;
    r.x = (unsigned)__builtin_amdgcn_ds_bpermute(src, (int)w.x); r.y = (unsigned)__builtin_amdgcn_ds_bpermute(src, (int)w.y); r.z = (unsigned)__builtin_amdgcn_ds_bpermute(src, (int)w.z); r.w = (unsigned)__builtin_amdgcn_ds_bpermute(src, (int)w.w); return r; }
typedef f32x4 Acc[2][2][4][2];

struct EpiP1 {
    static constexpr bool HOOK = false;
    unsigned char* ws; float* out; const float* bgate;
    DI void mid(Acc&, const Unit&, int, int, int, int, int) const {}
    DI void operator()(Acc& acc, const Unit& u, int wr, int wc, int fr, int fq) const {
        const int rl = wr * 64 + fr, cl = wc * 32 + 8 * fq;
        float* pf = nullptr; bf16_t* pb = nullptr; unsigned ld = 0; int act = 0; float scale = 1.f; const float* bias = nullptr; bool ok0 = true, ok1 = true;
        const int k = u.kind;
        if (k == 0) {
            const int wp = u.on; const size_t r0 = (size_t)u.om * 256;
            if (wp < WP_Q) { pf = (float*)(ws + WS_U) + r0 * 512 + wp * 256; ld = 512; }
            else if (wp < WP_K) { pb = (bf16_t*)(ws + WS_Q) + r0 * 512 + (wp - WP_Q) * 256; ld = 512; }
            else if (wp < WP_MQ) { pb = (bf16_t*)(ws + WS_K) + r0 * 512 + (wp - WP_K) * 256; ld = 512; }
            else if (wp < WP_ALR) { pb = (bf16_t*)(ws + WS_MQ) + r0 * 512 + (wp - WP_MQ) * 256; ld = 512; scale = MQ_SCALE; }
            else if (wp == WP_ALR) { pf = (float*)(ws + WS_ALR) + r0 * 16; ld = 16; ok0 = (cl < 16); ok1 = false; }
            else { pb = (bf16_t*)(ws + WS_G + (size_t)(u.om * 24 + (wp - WP_G)) * 65536); ld = 256; act = 2; bias = bgate + (wp - WP_G) * 256; }
        } else if (k == 1) { pb = (bf16_t*)(ws + WS_VRT) + (size_t)u.om * 256 * MTOK + u.on * 256; ld = MTOK; act = (u.om >= 4) ? 3 : 0; }
        else if (k == 2) { pf = out + O_MEMK + (size_t)u.om * 256 * 512 + u.on * 256; pb = (bf16_t*)(ws + WS_KM) + (size_t)u.om * 256 * 512 + u.on * 256; ld = 512; }
        else if (k == 3) { pf = out + O_MEMV + (size_t)u.om * 256 * 512 + u.on * 256; ld = 512; }
        else { pb = (bf16_t*)(ws + WS_VMT) + (size_t)u.om * 256 * 1024 + u.on * 256; ld = 1024; }
        const unsigned lo32 = (unsigned)rl * ld + (unsigned)cl;
        const int lane = fr + 16 * fq; const unsigned lq32 = (unsigned)(wr * 64 + (lane >> 2)) * ld + (unsigned)(wc * 32 + 8 * (lane & 3));
#pragma unroll
        for (int bj = 0; bj < 2; ++bj) {
            if (bj == 0 ? !ok0 : !ok1) continue;
            f32x4 b0 = {0.f, 0.f, 0.f, 0.f}, b1 = b0;
            if (act == 2) { b0 = *(const f32x4*)(bias + cl + bj * HALF); b1 = *(const f32x4*)(bias + cl + bj * HALF + 4); }
#pragma unroll
            for (int ai = 0; ai < 2; ++ai)
#pragma unroll
                for (int m = 0; m < 4; ++m) {
                    const size_t uo = (size_t)((ai * HALF + m * 16) * ld + bj * HALF);
                    f32x4 v0 = acc[ai][bj][m][0], v1 = acc[ai][bj][m][1];
                    if (act == 2) {
                        unsigned q[8];
#pragma unroll
                        for (int e = 0; e < 4; ++e) {
                            q[e] = (unsigned)fmaxf(__builtin_amdgcn_rcpf(1.0f + __builtin_amdgcn_exp2f((v0[e] + b0[e]) * -1.4426950408889634f)) * 255.0f + 0.5f, 1.0f);
                            q[4 + e] = (unsigned)fmaxf(__builtin_amdgcn_rcpf(1.0f + __builtin_amdgcn_exp2f((v1[e] + b1[e]) * -1.4426950408889634f)) * 255.0f + 0.5f, 1.0f); }
                        u32x2 w; w.x = q[0] | (q[1] << 8) | (q[2] << 16) | (q[3] << 24); w.y = q[4] | (q[5] << 8) | (q[6] << 16) | (q[7] << 24);
                        *(u32x2*)((unsigned char*)pb + (size_t)(((ai * 4 + m) * 2 + bj) * 8 + wr * 4 + wc) * 512 + lane * 8) = w;
                        continue;
                    } else if (act == 3) {
#pragma unroll
                        for (int e = 0; e < 4; ++e) { v0[e] = v0[e] * fsigmoid(v0[e]); v1[e] = v1[e] * fsigmoid(v1[e]); }
                    } else { v0 = v0 * scale; v1 = v1 * scale; }
                    if (pf) { float* p = pf + uo; *(f32x4*)(p + lo32) = v0; *(f32x4*)(p + lo32 + 4) = v1; }
                    if (pb) { bf16_t* p = pb + uo; *(u32x4*)(p + lq32) = quad16(pack8(v0, v1), lane); }
                }
        }
    }
};

DI float ub8(unsigned w, int k) { return (float)((w >> (8 * k)) & 0xffu); }
struct EpiMerge {
    static constexpr bool HOOK = true;
    unsigned char* ws;
    DI void mid(Acc& acc, const Unit& u, int t, int wr, int wc, int fr, int fq) const {
        if (t != 8 && t != 24) return;
        const unsigned lo8 = (unsigned)(((wr * 4 + wc) * 64 + fr + 16 * fq) * 8);
        const unsigned char* gp = ws + WS_G + (size_t)(u.om * 24 + (t == 8 ? 0 : 8) + u.on) * 65536;
        u32x2 ga[2][4][2], gb[2][4][2];
#pragma unroll
        for (int ai = 0; ai < 2; ++ai)
#pragma unroll
            for (int m = 0; m < 4; ++m)
#pragma unroll
                for (int bj = 0; bj < 2; ++bj) { const unsigned char* p = gp + (size_t)(((ai * 4 + m) * 2 + bj) * 4096); ga[ai][m][bj] = *(const u32x2*)(p + lo8); gb[ai][m][bj] = *(const u32x2*)(p + 8 * 65536 + lo8); }
#pragma unroll
        for (int ai = 0; ai < 2; ++ai)
#pragma unroll
            for (int m = 0; m < 4; ++m)
#pragma unroll
                for (int bj = 0; bj < 2; ++bj) { const u32x2 a = ga[ai][m][bj], b = gb[ai][m][bj];
                    f32x4 r0, r1;
#pragma unroll
                    for (int e = 0; e < 4; ++e) { r0[e] = ub8(a.x, e) * __builtin_amdgcn_rcpf(ub8(b.x, e)); r1[e] = ub8(a.y, e) * __builtin_amdgcn_rcpf(ub8(b.y, e)); }
                    acc[ai][bj][m][0] *= r0; acc[ai][bj][m][1] *= r1; }
        asm volatile("" ::: "memory");
    }
    DI void operator()(Acc& acc, const Unit& u, int wr, int wc, int fr, int fq) const {
        const int lane = fr + 16 * fq;
        const unsigned lg8 = (unsigned)(((wr * 4 + wc) * 64 + lane) * 8), lo32 = (unsigned)(wr * 64 + (lane >> 2)) * (unsigned)DM + (unsigned)(wc * 32 + 8 * (lane & 3));
        const unsigned char* gp = ws + WS_G + (size_t)(u.om * 24 + 16 + u.on) * 65536;
        bf16_t* op = (bf16_t*)(ws + WS_MG) + (size_t)u.om * 256 * DM + u.on * 256;
#pragma unroll
        for (int ai = 0; ai < 2; ++ai) {
            u32x2 ga[4][2];
#pragma unroll
            for (int m = 0; m < 4; ++m)
#pragma unroll
                for (int bj = 0; bj < 2; ++bj) ga[m][bj] = *(const u32x2*)(gp + (size_t)(((ai * 4 + m) * 2 + bj) * 4096) + lg8);
#pragma unroll
            for (int m = 0; m < 4; ++m)
#pragma unroll
                for (int bj = 0; bj < 2; ++bj) { const u32x2 a = ga[m][bj];
                    f32x4 v0 = acc[ai][bj][m][0], v1 = acc[ai][bj][m][1];
#pragma unroll
                    for (int e = 0; e < 4; ++e) { v0[e] *= ub8(a.x, e) * (1.0f / 255.0f); v1[e] *= ub8(a.y, e) * (1.0f / 255.0f); }
                    *(u32x4*)(op + (size_t)((ai * HALF + m * 16) * DM + bj * HALF) + lo32) = quad16(pack8(v0, v1), lane); }
            asm volatile("" ::: "memory");
        }
    }
};

struct EpiNorm {
    static constexpr bool HOOK = false;
    bf16_t* Y; float* SSQ; float* PART;
    DI void mid(Acc&, const Unit&, int, int, int, int, int) const {}
    DI void operator()(Acc& acc, const Unit& u, int wr, int wc, int fr, int fq) const {
        if (u.kind != 0) {
            float* pp = PART + ((size_t)(u.kind - 1) * 1024 + (size_t)(u.om - 64) * 256) * DM + u.on * 256;
            const unsigned lp32 = (unsigned)(wr * 64 + fr) * (unsigned)DM + (unsigned)(wc * 32 + 8 * fq);
#pragma unroll
            for (int ai = 0; ai < 2; ++ai)
#pragma unroll
                for (int m = 0; m < 4; ++m)
#pragma unroll
                    for (int bj = 0; bj < 2; ++bj) { float* p = pp + (size_t)((ai * HALF + m * 16) * DM + bj * HALF); *(f32x4*)(p + lp32) = acc[ai][bj][m][0]; *(f32x4*)(p + lp32 + 4) = acc[ai][bj][m][1]; }
            return;
        }
        const int lane = fr + 16 * fq;
        const unsigned lo32 = (unsigned)(wr * 64 + (lane >> 2)) * (unsigned)DM + (unsigned)(wc * 32 + 8 * (lane & 3)), ls32 = (unsigned)(wr * 64 + fr) * 32u;
        bf16_t* op = Y + (size_t)u.om * 256 * DM + u.on * 256; float* sp = SSQ + (size_t)u.om * 256 * 32 + u.on * 4 + wc;
#pragma unroll
        for (int ai = 0; ai < 2; ++ai)
#pragma unroll
            for (int m = 0; m < 4; ++m) {
                float s = 0.f;
#pragma unroll
                for (int bj = 0; bj < 2; ++bj) {
                    const f32x4 v0 = acc[ai][bj][m][0], v1 = acc[ai][bj][m][1];
                    s += (v0[0] * v0[0] + v0[1] * v0[1]) + (v0[2] * v0[2] + v0[3] * v0[3]) + (v1[0] * v1[0] + v1[1] * v1[1]) + (v1[2] * v1[2] + v1[3] * v1[3]);
                    *(u32x4*)(op + (size_t)((ai * HALF + m * 16) * DM + bj * HALF) + lo32) = quad16(pack8(v0, v1), lane);
                }
                s += __shfl_xor(s, 16); s += __shfl_xor(s, 32);
                if (fq == 0) sp[(size_t)((ai * HALF + m * 16) * 32) + ls32] = s;
            }
    }
};

DI float gelu_tanh_f(float x) { const float z = 1.5957691216057308f * (x + 0.044715f * x * x * x); return x * __builtin_amdgcn_rcpf(1.0f + __expf(-z)); }
DI void unpack8(u32x4 w, float (&v)[8]) { v[0] = bf_lo(w.x); v[1] = bf_hi(w.x); v[2] = bf_lo(w.y); v[3] = bf_hi(w.y); v[4] = bf_lo(w.z); v[5] = bf_hi(w.z); v[6] = bf_lo(w.w); v[7] = bf_hi(w.w); }
DI void unpack4(u32x2 w, float (&v)[4]) { v[0] = bf_lo(w.x); v[1] = bf_hi(w.x); v[2] = bf_lo(w.y); v[3] = bf_hi(w.y); }
constexpr int UPC_A = 3 * 16384, UPC_B = 131072 + 1024, UPC_CARRY = UPC_B + 16384;
struct EpiUpConv {
    static constexpr bool HOOK = false;
    unsigned char* ws; float* out; const float* wdw; const float* bdw; const float* hist; LAS unsigned char* lds;
    DI void mid(Acc&, const Unit&, int, int, int, int, int) const {}
    DI void operator()(Acc& acc, const Unit& u, int wr, int wc, int fr, int fq) const {
        const bool sample = u.om >= 64, contin = !sample && (u.om & 15) != 0;
        int tid = threadIdx.x; asm volatile("" : "+v"(tid));
        fr = tid & 15; fq = (tid >> 4) & 3;
        const int fgp = tid & 31, rg = tid >> 5, feat = u.on * 128 + fgp * 4;
        f32x4 wg[3], wv[3], bg, bv;
#pragma unroll
        for (int i = 0; i < 3; ++i) { wg[i] = *(const f32x4*)(wdw + (size_t)i * F2 + feat); wv[i] = *(const f32x4*)(wdw + (size_t)i * F2 + FF + feat); }
        bg = *(const f32x4*)(bdw + feat); bv = *(const f32x4*)(bdw + FF + feat);
        u32x4 pk[2][4][2];
        {
            const int rl = wr * 64 + fr, cl = wc * 32 + 8 * fq;
#pragma unroll
            for (int ai = 0; ai < 2; ++ai)
#pragma unroll
                for (int m = 0; m < 4; ++m) {
                    const int row = rl + ai * HALF + m * 16, gm = u.om * 256 + row; float* cp = nullptr;
                    if (!sample) { const int t = gm & 4095; if (t >= 4094) cp = out + O_CONVP + ((size_t)(gm >> 12) * 2 + (t - 4094)) * F2; }
                    else { const int t = (gm - NPROMPT) & 31; if (t >= 30) cp = out + O_CONVS + ((size_t)((gm - NPROMPT) >> 5) * 2 + (t - 30)) * F2; }
                    if (cp) {
#pragma unroll
                        for (int bj = 0; bj < 2; ++bj) { float* q = cp + bj * FF + u.on * 128 + cl; *(f32x4*)q = acc[ai][bj][m][0]; *(f32x4*)(q + 4) = acc[ai][bj][m][1]; } }
#pragma unroll
                    for (int bj = 0; bj < 2; ++bj) pk[ai][m][bj] = pack8(acc[ai][bj][m][0], acc[ai][bj][m][1]);
                }
        }
        LAS unsigned char* chA = lds + UPC_A; LAS unsigned char* chB = lds + UPC_B; LAS unsigned char* carry = lds + UPC_CARRY;
#pragma unroll
        for (int c = 0; c < 4; ++c) {
            if (wr == (c & 1)) {
#pragma unroll
                for (int m = 0; m < 4; ++m)
#pragma unroll
                    for (int bj = 0; bj < 2; ++bj) { const int row = m * 16 + fr, gran = bj * 16 + wc * 4 + fq;
                        *(LAS u32x4*)(((row & 32) ? chB : chA) + (row & 31) * 512 + ((gran ^ (row & 31)) << 4)) = pk[c >> 1][m][bj]; }
            }
            asm volatile("s_waitcnt lgkmcnt(0)" ::: "memory"); __builtin_amdgcn_s_barrier(); asm volatile("" ::: "memory");
            u32x2 gr[6], vr[6];
#pragma unroll
            for (int i = 0; i < 6; ++i) {
                const int r = 4 * rg - 2 + i;
                if (i >= 2 || rg > 0) { const LAS unsigned char* p = ((r & 32) ? chB : chA) + (r & 31) * 512; const int sw = r & 31;
                    gr[i] = *(const LAS u32x2*)(p + (((fgp >> 1) ^ sw) << 4) + (fgp & 1) * 8); vr[i] = *(const LAS u32x2*)(p + (((16 + (fgp >> 1)) ^ sw) << 4) + (fgp & 1) * 8); }
                else if (c > 0) { const LAS unsigned char* q = carry + ((c - 1) & 1) * 1024 + i * 512; gr[i] = *(const LAS u32x2*)(q + fgp * 8); vr[i] = *(const LAS u32x2*)(q + 256 + fgp * 8); }
                else { gr[i] = (u32x2){0u, 0u}; vr[i] = gr[i]; }
            }
            f32x2 G[6][2], V[6][2];
#pragma unroll
            for (int i = 0; i < 6; ++i) { float t4[4]; unpack4(gr[i], t4); G[i][0] = (f32x2){t4[0], t4[1]}; G[i][1] = (f32x2){t4[2], t4[3]}; unpack4(vr[i], t4); V[i][0] = (f32x2){t4[0], t4[1]}; V[i][1] = (f32x2){t4[2], t4[3]}; }
            if (sample && (rg & 7) == 0) {
                const int b = ((u.om - 64) * 256 + c * 64 + 4 * rg) >> 5; const float* hp = hist + (size_t)b * 2 * F2 + feat;
                const f32x4 a0 = *(const f32x4*)hp, a1 = *(const f32x4*)(hp + F2), c0 = *(const f32x4*)(hp + FF), c1 = *(const f32x4*)(hp + F2 + FF);
                G[0][0] = (f32x2){a0[0], a0[1]}; G[0][1] = (f32x2){a0[2], a0[3]}; G[1][0] = (f32x2){a1[0], a1[1]}; G[1][1] = (f32x2){a1[2], a1[3]};
                V[0][0] = (f32x2){c0[0], c0[1]}; V[0][1] = (f32x2){c0[2], c0[3]}; V[1][0] = (f32x2){c1[0], c1[1]}; V[1][1] = (f32x2){c1[2], c1[3]};
            }
            if (!sample && ((c == 0 && rg == 0) || (c == 3 && rg == 15))) {
                float* hp = (float*)(ws + (c == 0 ? WS_HEAD : WS_TAIL)) + (size_t)u.om * 2 * F2 + feat;
#pragma unroll
                for (int rr = 0; rr < 2; ++rr) { const int ri = (c == 0 ? 2 : 4) + rr;
                    *(f32x4*)(hp + (size_t)rr * F2) = (f32x4){G[ri][0].x, G[ri][0].y, G[ri][1].x, G[ri][1].y}; *(f32x4*)(hp + (size_t)rr * F2 + FF) = (f32x4){V[ri][0].x, V[ri][0].y, V[ri][1].x, V[ri][1].y}; }
            }
            bf16_t* op = (bf16_t*)(ws + WS_HG) + ((size_t)u.om * 256 + c * 64 + 4 * rg) * FF + feat;
            const f32x2 K1 = {-2.3022082f, -2.3022082f}, K3 = {-0.10294324f, -0.10294324f}, ONE = {1.0f, 1.0f};
            f32x2 CG[4][2], CV[4][2], UU[4][2];
#pragma unroll
            for (int p = 0; p < 2; ++p) {
                const f32x2 w0 = {wg[0][2 * p], wg[0][2 * p + 1]}, w1 = {wg[1][2 * p], wg[1][2 * p + 1]}, w2 = {wg[2][2 * p], wg[2][2 * p + 1]}, wb = {bg[2 * p], bg[2 * p + 1]};
                const f32x2 x0 = {wv[0][2 * p], wv[0][2 * p + 1]}, x1 = {wv[1][2 * p], wv[1][2 * p + 1]}, x2 = {wv[2][2 * p], wv[2][2 * p + 1]}, xb = {bv[2 * p], bv[2 * p + 1]};
#pragma unroll
                for (int i = 0; i < 4; ++i) { CG[i][p] = w0 * G[i][p] + (w1 * G[i + 1][p] + (w2 * G[i + 2][p] + wb)); CV[i][p] = x0 * V[i][p] + (x1 * V[i + 1][p] + (x2 * V[i + 2][p] + xb)); }
            }
#pragma unroll
            for (int i = 0; i < 4; ++i)
#pragma unroll
                for (int p = 0; p < 2; ++p) UU[i][p] = CG[i][p] * (CG[i][p] * CG[i][p] * K3 + K1);
#pragma unroll
            for (int i = 0; i < 4; ++i)
#pragma unroll
                for (int p = 0; p < 2; ++p) UU[i][p] = (f32x2){__builtin_amdgcn_exp2f(UU[i][p].x), __builtin_amdgcn_exp2f(UU[i][p].y)} + ONE;
#pragma unroll
            for (int i = 0; i < 4; ++i)
#pragma unroll
                for (int p = 0; p < 2; ++p) UU[i][p] = (f32x2){__builtin_amdgcn_rcpf(UU[i][p].x), __builtin_amdgcn_rcpf(UU[i][p].y)};
#pragma unroll
            for (int i = 0; i < 4; ++i) {
                const f32x2 h0 = CG[i][0] * UU[i][0] * CV[i][0], h1 = CG[i][1] * UU[i][1] * CV[i][1];
                if (!(contin && c == 0 && rg == 0 && i < 2)) { u32x2 w; w.x = pk_bf16(h0.x, h0.y); w.y = pk_bf16(h1.x, h1.y); *(u32x2*)(op + (size_t)i * FF) = w; }
            }
            if (c < 3 && rg == 15) { LAS unsigned char* q = carry + (c & 1) * 1024 + fgp * 8;
                *(LAS u32x2*)q = gr[4]; *(LAS u32x2*)(q + 256) = vr[4]; *(LAS u32x2*)(q + 512) = gr[5]; *(LAS u32x2*)(q + 768) = vr[5]; }
            asm volatile("s_waitcnt lgkmcnt(0)" ::: "memory"); __builtin_amdgcn_s_barrier(); asm volatile("" ::: "memory");
        }
        if (sample) {
            asm volatile("s_waitcnt vmcnt(0)" ::: "memory"); __builtin_amdgcn_s_barrier(); asm volatile("" ::: "memory");
            if (threadIdx.x == 0) { __builtin_amdgcn_fence(__ATOMIC_RELEASE, "agent"); (void)__hip_atomic_fetch_add((unsigned*)(ws + WS_CTL) + CW_UPDONE + (u.om - 64) * 32, 1u, __ATOMIC_RELAXED, __HIP_MEMORY_SCOPE_AGENT); }
        }
    }
};

template <class Epi, class Sched>
DI void gemm_phase(LAS unsigned char* lds, const Gemm g, const Sched& S, const Epi& E) {
    const int tid = threadIdx.x, wid = __builtin_amdgcn_readfirstlane(tid >> 6), lane = tid & 63, wr = wid >> 2, wc = wid & 3, fr = lane & 15, fq = lane >> 4;
    unsigned voffA[2], voffB[2];
#pragma unroll
    for (int i = 0; i < 2; ++i) { int R, C; stage_rc(tid * 16 + i * 8192, R, C); const int Rb = (R & ~31) + perm32(R & 31);
        voffA[i] = (unsigned)(R * g.lda + C) * 2u; voffB[i] = (unsigned)(Rb * g.ldb + C) * 2u; }
    const size_t kstep = (size_t)(BK * 2);
    const size_t hstepA = (size_t)HALF * g.lda * 2, hstepB = (size_t)HALF * g.ldb * 2;
    const size_t rstepA = (size_t)g.lda * 2, rstepB = (size_t)g.ldb * 2;
    const unsigned ldsw = (unsigned)wid * 1024u;
    const int aoff = lds_byte(wr * 64 + fr, fq * 8), boff = lds_byte(wc * 32 + fr, fq * 8);
#define PG8_SA(b, h) (((b) * 2 + (h)) * HTB)
#define PG8_SB(b, h) ((4 + (b) * 2 + (h)) * HTB)
#define PG8_STAGE(bufoff, gbase, voff) do { _Pragma("unroll") for (int _i = 0; _i < 2; ++_i) \
        __builtin_amdgcn_global_load_lds((const unsigned*)((const char*)(gbase) + (voff)[_i]), (LAS unsigned*)(lds + (bufoff) + ldsw + _i * 8192), 16, 0, 0); } while (0)
#define PG8_LDA(dst, b, h) do { _Pragma("unroll") for (int m = 0; m < 4; ++m) _Pragma("unroll") for (int k = 0; k < 2; ++k) dst[m][k] = *(const LAS bf16x8*)(lds + PG8_SA(b, h) + aoff + m * 2048 + k * 1024); } while (0)
#define PG8_LDB(dst, b, h) do { _Pragma("unroll") for (int n = 0; n < 2; ++n) _Pragma("unroll") for (int k = 0; k < 2; ++k) dst[n][k] = *(const LAS bf16x8*)(lds + PG8_SB(b, h) + boff + n * 2048 + k * 1024); } while (0)
#define PG8_MMA(ai, bj, At, Bt) do { __builtin_amdgcn_s_setprio(1); _Pragma("unroll") for (int m = 0; m < 4; ++m) _Pragma("unroll") for (int n = 0; n < 2; ++n) _Pragma("unroll") for (int k = 0; k < 2; ++k) \
        acc[ai][bj][m][n] = __builtin_amdgcn_mfma_f32_16x16x32_bf16(Bt[n][k], At[m][k], acc[ai][bj][m][n], 0, 0, 0); __builtin_amdgcn_s_setprio(0); } while (0)
#define PG8_WAIT_V(n) asm volatile("s_waitcnt vmcnt(" #n ")" ::: "memory")
#define PG8_WAIT_L(n) asm volatile("s_waitcnt lgkmcnt(" #n ")" ::: "memory")
#define PG8_BAR __builtin_amdgcn_s_barrier()
#define PG8_SCHED __builtin_amdgcn_sched_barrier(0)
    Unit cur, nxt; int ui = 0;
    if (!S.next(0, cur)) return;
    Acc acc;
#pragma unroll
    for (int a = 0; a < 2; ++a)
#pragma unroll
        for (int b = 0; b < 2; ++b)
#pragma unroll
            for (int m = 0; m < 4; ++m)
#pragma unroll
                for (int n = 0; n < 2; ++n) acc[a][b][m][n] = (f32x4){0.f, 0.f, 0.f, 0.f};
    bf16x8 At[4][2], B0[2][2], B1[2][2];
    const char* cA = (const char*)g.A + (size_t)cur.arow * rstepA + (size_t)cur.koff * 2; const char* cB = (const char*)g.B + (size_t)cur.brow * rstepB + (size_t)cur.koff * 2;
    PG8_STAGE(PG8_SB(0, 0), cB, voffB); PG8_STAGE(PG8_SB(0, 1), cB + hstepB, voffB); PG8_STAGE(PG8_SA(0, 0), cA, voffA); PG8_STAGE(PG8_SA(0, 1), cA + hstepA, voffA);
    if (wr == 1) PG8_BAR;
    PG8_WAIT_V(2); PG8_BAR;
    PG8_STAGE(PG8_SB(1, 0), cB + kstep, voffB); PG8_STAGE(PG8_SA(1, 0), cA + kstep, voffA); PG8_STAGE(PG8_SB(1, 1), cB + hstepB + kstep, voffB);
    PG8_WAIT_V(6); PG8_BAR;
    for (;;) {
        const bool has_next = S.next(ui + 1, nxt);
        const char* nA = has_next ? (const char*)g.A + (size_t)nxt.arow * rstepA + (size_t)nxt.koff * 2 : cA; const char* nB = has_next ? (const char*)g.B + (size_t)nxt.brow * rstepB + (size_t)nxt.koff * 2 : cB;
        const int nt = cur.nt;
        for (int t = 0; t < nt; t += 2) {
            const bool last = (t == nt - 2);
            const char* a1 = cA + (size_t)(t + 1) * kstep;
            const char* a2 = last ? nA : cA + (size_t)(t + 2) * kstep; const char* b2 = last ? nB : cB + (size_t)(t + 2) * kstep;
            const char* a3 = a2 + kstep; const char* b3 = b2 + kstep;
            if constexpr (Epi::HOOK) E.mid(acc, cur, t, wr, wc, fr, fq);
            PG8_LDB(B0, 0, 0); PG8_LDB(B1, 0, 1); PG8_SCHED; PG8_LDA(At, 0, 0); PG8_STAGE(PG8_SA(1, 1), a1 + hstepA, voffA);
            PG8_WAIT_V(8); PG8_WAIT_L(0); PG8_BAR; PG8_MMA(0, 0, At, B0); PG8_MMA(0, 1, At, B1); PG8_BAR; PG8_SCHED;
            PG8_LDA(At, 0, 1); PG8_STAGE(PG8_SB(0, 0), b2, voffB); PG8_STAGE(PG8_SB(0, 1), b2 + hstepB, voffB); PG8_STAGE(PG8_SA(0, 0), a2, voffA);
            PG8_WAIT_V(8); PG8_WAIT_L(0); PG8_BAR; PG8_MMA(1, 0, At, B0); PG8_MMA(1, 1, At, B1); PG8_BAR; PG8_SCHED;
            PG8_LDB(B0, 1, 0); PG8_LDB(B1, 1, 1); PG8_SCHED; PG8_LDA(At, 1, 0); PG8_STAGE(PG8_SA(0, 1), a2 + hstepA, voffA);
            PG8_WAIT_V(8); PG8_WAIT_L(0); PG8_BAR; PG8_MMA(0, 0, At, B0); PG8_MMA(0, 1, At, B1); PG8_BAR; PG8_SCHED;
            PG8_LDA(At, 1, 1); PG8_STAGE(PG8_SB(1, 0), b3, voffB); PG8_STAGE(PG8_SB(1, 1), b3 + hstepB, voffB); PG8_STAGE(PG8_SA(1, 0), a3, voffA);
            PG8_WAIT_V(8); PG8_WAIT_L(0); PG8_BAR; PG8_MMA(1, 0, At, B0); PG8_MMA(1, 1, At, B1); PG8_BAR; PG8_SCHED;
        }
        if (wr == 0) PG8_BAR;
        cur.seq = ui; E(acc, cur, wr, wc, fr, fq);
        if (!has_next) break;
#pragma unroll
        for (int a = 0; a < 2; ++a)
#pragma unroll
            for (int b = 0; b < 2; ++b)
#pragma unroll
                for (int m = 0; m < 4; ++m)
#pragma unroll
                    for (int n = 0; n < 2; ++n) acc[a][b][m][n] = (f32x4){0.f, 0.f, 0.f, 0.f};
        cur = nxt; cA = nA; cB = nB; ++ui;
        if (wr == 1) PG8_BAR;
    }
    PG8_WAIT_V(0);
    PG8_BAR;
#undef PG8_SA
#undef PG8_SB
#undef PG8_STAGE
#undef PG8_LDA
#undef PG8_LDB
#undef PG8_MMA
#undef PG8_WAIT_V
#undef PG8_WAIT_L
#undef PG8_BAR
#undef PG8_SCHED
}
}

#define XB_TMO      128
#define XB_XCNT(j)  (256  + 64 * (j))
#define XB_XSUB(j)  (1280 + 64 * (j))
#define XB_XGEN(j)  (2304 + 64 * (j))
#define XB_TOP      3328
#define XB_TOPGEN   3392
#define XCD_BAR_WORDS 3456
#define XB_SPIN_CAP (1u << 18)
DI unsigned xb_ld(unsigned* p)              { return __hip_atomic_load(p, __ATOMIC_RELAXED, __HIP_MEMORY_SCOPE_AGENT); }
DI unsigned xb_add(unsigned* p, unsigned v) { return __hip_atomic_fetch_add(p, v, __ATOMIC_RELAXED, __HIP_MEMORY_SCOPE_AGENT); }
DI unsigned xb_xcc_id() { return (unsigned)__builtin_amdgcn_s_getreg((3 << 11) | 20) & 0xFu; }
#define XB_SPIN(cond, bar) do { unsigned _sp = 0; while (cond) { __builtin_amdgcn_s_sleep(1); \
    if ((++_sp & 255u) == 0u) { if (xb_ld(&(bar)[XB_TMO])) break; if (_sp > XB_SPIN_CAP) { atomicAdd(&(bar)[XB_TMO], 1u); break; } } } } while (0)
struct XcdBarrier { unsigned* bar; unsigned x; volatile LAS unsigned* st; };
DI XcdBarrier xcd_barrier_post(unsigned* bar, volatile LAS unsigned* st) {
    XcdBarrier b; b.bar = bar; b.x = xb_xcc_id(); b.st = st;
    if (threadIdx.x == 0) (void)xb_add(&bar[XB_XCNT(b.x)], 1u);
    return b;
}
DI void xcd_barrier_complete(unsigned* bar, unsigned x, unsigned& nloc, unsigned& nx) {
    const unsigned G = gridDim.x * gridDim.y * gridDim.z;
    unsigned sum, cnt, mine, sp = 0u;
    for (;;) {
        sum = 0u; cnt = 0u; mine = 0u;
#pragma unroll
        for (unsigned j = 0; j < 16; ++j) { const unsigned c = xb_ld(&bar[XB_XCNT(j)]); sum += c; cnt += (c > 0u) ? 1u : 0u; mine = (j == x) ? c : mine; }
        if (sum == G) break;
        __builtin_amdgcn_s_sleep(1);
        if ((++sp & 255u) == 0u) { if (xb_ld(&bar[XB_TMO])) break; if (sp > XB_SPIN_CAP) { atomicAdd(&bar[XB_TMO], 1u); break; } }
    }
    nloc = mine > 0u ? mine : 1u; nx = cnt > 0u ? cnt : 1u;
}
DI void xcd_barrier(const XcdBarrier& b) {
    asm volatile("s_waitcnt vmcnt(0)" ::: "memory");
    __syncthreads();
    if (threadIdx.x == 0) {
        unsigned* bar = b.bar;
        __builtin_amdgcn_s_waitcnt(0);
        unsigned nloc = b.st[0], nx = b.st[1];
        if (nloc == 0u) { xcd_barrier_complete(bar, b.x, nloc, nx); b.st[0] = nloc; b.st[1] = nx; }
        const unsigned old = xb_add(&bar[XB_XSUB(b.x)], 1u);
        const unsigned gen = old / nloc;
        if (old + 1u == (gen + 1u) * nloc) {
            __builtin_amdgcn_fence(__ATOMIC_RELEASE, "agent");
            asm volatile("s_waitcnt vmcnt(0)" ::: "memory");
            const unsigned og = xb_add(&bar[XB_TOP], 1u);
            const unsigned tg = og / nx;
            if (og + 1u == (tg + 1u) * nx) xb_add(&bar[XB_TOPGEN], 1u);
            else XB_SPIN(xb_ld(&bar[XB_TOPGEN]) == tg, bar);
            __builtin_amdgcn_fence(__ATOMIC_ACQUIRE, "agent");
            xb_add(&bar[XB_XGEN(b.x)], 1u);
            asm volatile("s_waitcnt vmcnt(0)" ::: "memory");
        } else {
            XB_SPIN(xb_ld(&bar[XB_XGEN(b.x)]) == gen, bar);
            __builtin_amdgcn_fence(__ATOMIC_ACQUIRE, "agent");
            asm volatile("s_waitcnt vmcnt(0)" ::: "memory");
        }
    }
    __syncthreads();
}

#define LDS_WAIT() asm volatile("s_waitcnt lgkmcnt(0)" ::: "memory")
DI float wave_sum(float v) {
#pragma unroll
    for (int o = 1; o < 64; o <<= 1) v += __shfl_xor(v, o);
    return v;
}
DI void tr_item(const float* W, size_t ldw, int col, int k0, bf16_t* dst, size_t dld, LAS float* scr, int lane) {
    float tv[32];
    { const float* wp0 = W + (size_t)(k0 + (lane >> 5)) * ldw + col + (lane & 31);
#pragma unroll
      for (int i = 0; i < 32; ++i) tv[i] = wp0[(size_t)(2 * i) * ldw]; }
#pragma unroll
    for (int i = 0; i < 32; ++i) { const int kk = 2 * i + (lane >> 5); scr[kk * 33 + (lane & 31)] = tv[i]; }
    LDS_WAIT(); asm volatile("" ::: "memory");
    const int c = lane & 7;
#pragma unroll
    for (int j = 0; j < 4; ++j) { const int n = (lane >> 3) + 8 * j; const LAS float* s = scr + (8 * c) * 33 + n;
        u32x4 o; o.x = pk_bf16(s[0 * 33], s[1 * 33]); o.y = pk_bf16(s[2 * 33], s[3 * 33]); o.z = pk_bf16(s[4 * 33], s[5 * 33]); o.w = pk_bf16(s[6 * 33], s[7 * 33]);
        *(u32x4*)(dst + (size_t)n * dld + 8 * c) = o; }
    LDS_WAIT(); asm volatile("" ::: "memory");
}
struct TrSrc { const float* src; bf16_t* dst; unsigned ldw, dld; };
DI void tr_load(float (&tv)[32], const TrSrc& t, int lane) {
    const float* wp0 = t.src + (size_t)(lane >> 5) * t.ldw + (lane & 31);
#pragma unroll
    for (int i = 0; i < 32; ++i) tv[i] = wp0[(size_t)(2 * i) * t.ldw];
}
DI void tr_store(const float (&tv)[32], const TrSrc& t, LAS float* scr, int lane) {
#pragma unroll
    for (int i = 0; i < 32; ++i) { const int kk = 2 * i + (lane >> 5); scr[kk * 33 + (lane & 31)] = tv[i]; }
    LDS_WAIT(); asm volatile("" ::: "memory");
    const int c = lane & 7;
#pragma unroll
    for (int j = 0; j < 4; ++j) { const int n = (lane >> 3) + 8 * j; const LAS float* s = scr + (8 * c) * 33 + n;
        u32x4 o; o.x = pk_bf16(s[0 * 33], s[1 * 33]); o.y = pk_bf16(s[2 * 33], s[3 * 33]); o.z = pk_bf16(s[4 * 33], s[5 * 33]); o.w = pk_bf16(s[6 * 33], s[7 * 33]);
        *(u32x4*)(t.dst + (size_t)n * t.dld + 8 * c) = o; }
    LDS_WAIT(); asm volatile("" ::: "memory");
}
template <class DEC> DI void tr_pipeline(DEC dec, int i0, int i1, int g, int NG, LAS float* scr, int lane) {
    int it = i0 + g;
    if (it >= i1) return;
    float A[32], B[32];
    TrSrc ta = dec(it), tb;
    tr_load(A, ta, lane);
    while (true) {
        int nx = it + NG; bool more = nx < i1;
        tb = dec(more ? nx : it); tr_load(B, tb, lane);
        tr_store(A, ta, scr, lane);
        if (!more) break;
        it = nx; nx = it + NG; more = nx < i1;
        ta = dec(more ? nx : it); tr_load(A, ta, lane);
        tr_store(B, tb, scr, lane);
        if (!more) break;
        it = nx;
    }
}
DI void rms_row_to_bf16(const float* xrow, const float* gain, bf16_t* orow, int lane) {
    const f32x4* xr = (const f32x4*)xrow + lane; const f32x4* gr = (const f32x4*)gain + lane;
    f32x4 v[8]; float s = 0.f;
#pragma unroll
    for (int j = 0; j < 8; ++j) { v[j] = xr[64 * j]; s += (v[j].x * v[j].x + v[j].y * v[j].y) + (v[j].z * v[j].z + v[j].w * v[j].w); }
    const float rstd = 1.0f / sqrtf(wave_sum(s) * (1.f / DM) + EPS);
    u32x2* o8 = (u32x2*)orow + lane;
#pragma unroll
    for (int j = 0; j < 8; ++j) { const f32x4 gg = gr[64 * j]; u32x2 w; w.x = pk_bf16(v[j].x * rstd * gg.x, v[j].y * rstd * gg.y); w.y = pk_bf16(v[j].z * rstd * gg.z, v[j].w * rstd * gg.w); o8[64 * j] = w; }
}

struct Args { const float* in[31]; float* out; unsigned char* ws; int ph_lo, ph_hi, li, pad; };
constexpr int ARGS_DW = sizeof(Args) / 4;
constexpr int LDSARGS_OFF = MISC_OFF + 128;
#ifndef GMASK
#define GMASK 866
#endif
template <class T> DI T* as_global(T* p) { return (T*)(__attribute__((address_space(1))) T*)(unsigned long long)p; }
template <bool GL = false> DI Args fetch_args(LAS unsigned char* lds) {
    Args a; unsigned* w = (unsigned*)&a; const LAS unsigned* la = (const LAS unsigned*)(lds + LDSARGS_OFF);
#pragma unroll
    for (int i = 0; i < ARGS_DW; ++i) w[i] = (unsigned)__builtin_amdgcn_readfirstlane((int)la[i]);
    if (GL) {
#pragma unroll
        for (int i = 0; i < 31; ++i) a.in[i] = as_global(a.in[i]);
        a.out = as_global(a.out); a.ws = as_global(a.ws); }
    return a;
}

DI void p0_prologue(const Args& a, LAS unsigned char* lds, int gw, int NGW, int wave, int lane) {
    LAS float* scr = (LAS float*)(lds + wave * 16384);
    unsigned char* ws = a.ws;
    bf16_t* RB = (bf16_t*)(ws + WS_RB); bf16_t* WBt = (bf16_t*)(ws + WS_WB);
    const float* w_in = a.in[12]; const float* w_gate = a.in[18];
    constexpr int J_U = 512, J_Q = 512, J_K = 512, J_V = 1024, J_R = 1024, J_MQ = 512, J_G = 6144, J_MK = 512, J_MV = 512, J_BG = 1024, J_BM = 512, J_VS = 2048, J_WC = 2048;
    constexpr int NTR = J_U + J_Q + J_K + J_V + J_R + J_MQ + J_G + J_MK + J_MV + J_BG + J_BM + J_VS + J_WC;
    constexpr int NROW = MTOK + NMEMROWS, NKS = 2048, NPAD = 240;
    constexpr int NITEMS = NTR + NROW + NKS + NPAD;
    constexpr int NTRP = J_U + J_Q + J_K + J_V + J_R + J_MQ + J_G + J_MK + J_MV + J_BG + J_BM + J_VS;
    {
        const float* gw_in = as_global(w_in); const float* gw_gate = as_global(w_gate); const float* gmk = as_global(a.in[9]); const float* gmv = as_global(a.in[10]);
        const float* gbg = as_global(a.in[21]); const float* gbm = as_global(a.in[22]); const float* gvs = as_global(a.in[7]); unsigned char* gws = as_global(ws);
        tr_pipeline([=](int r) -> TrSrc { TrSrc t; bf16_t* gRB = (bf16_t*)(gws + WS_RB); bf16_t* gWB = (bf16_t*)(gws + WS_WB);
#define TRJ(cnt, srcp, ldw_, col0, ncols, dstp) if (r < (cnt)) { const int nb = (ncols) / 32, kb = r / nb, n0 = (r % nb) * 32; \
                t.src = (srcp) + (size_t)(kb * 64) * (ldw_) + (col0) + n0; t.ldw = (ldw_); t.dst = (dstp) + (size_t)n0 * DM + kb * 64; t.dld = DM; return t; } r -= (cnt);
            TRJ(J_U, gw_in, INW, 0, 512, gRB + (size_t)(PN_W + WP_U) * 256 * DM)
            TRJ(J_Q, gw_in, INW, 512, 512, gRB + (size_t)(PN_W + WP_Q) * 256 * DM)
            TRJ(J_K, gw_in, INW, 1024, 512, gRB + (size_t)(PN_W + WP_K) * 256 * DM)
            TRJ(J_V, gw_in, INW, 1536, 1024, gRB + (size_t)(PN_W + WP_V) * 256 * DM)
            TRJ(J_R, gw_in, INW, 2560, 1024, gRB + (size_t)(PN_W + WP_R) * 256 * DM)
            TRJ(J_MQ, gw_in, INW, 3600, 512, gRB + (size_t)(PN_W + WP_MQ) * 256 * DM)
            TRJ(J_G, gw_gate, 6144, 0, 6144, gRB + (size_t)(PN_W + WP_G) * 256 * DM)
            TRJ(J_MK, gmk, 512, 0, 512, gRB + (size_t)(PN_W + WP_MK) * 256 * DM)
            TRJ(J_MV, gmv, 512, 0, 512, gRB + (size_t)(PN_W + WP_MV) * 256 * DM)
#undef TRJ
            if (r < J_BG) { const int kb = r / 64, n0 = (r % 64) * 32; t.src = gbg + (size_t)(kb * 64) * 2048 + n0; t.ldw = 2048; t.dst = gWB + (size_t)n0 * DM + 512 + kb * 64; t.dld = DM; return t; } r -= J_BG;
            if (r < J_BM) { const int kb = r / 64, n0 = (r % 64) * 32; t.src = gbm + (size_t)(kb * 64) * 2048 + n0; t.ldw = 2048; t.dst = gWB + (size_t)n0 * DM + 1536 + kb * 64; t.dld = DM; return t; } r -= J_BM;
            { const int kb = r / 16, n0 = (r % 16) * 32; t.src = gvs + (size_t)(kb * 64) * 512 + n0; t.ldw = 512; t.dst = (bf16_t*)(gws + WS_VST) + (size_t)n0 * 8192 + kb * 64; t.dld = 8192; return t; }
        }, 0, NTRP, gw, NGW, scr, lane);
    }
    {
        const float* gx0 = as_global(a.in[0]); const float* gx1 = as_global(a.in[1]); const float* gx2 = as_global(a.in[2]); const float* gg0 = as_global(a.in[11]); const float* gg1 = as_global(a.in[8]);
        bf16_t* gRB = (bf16_t*)(as_global(ws) + WS_RB);
        auto src = [&](int r) -> const float* { return r < NPROMPT ? gx0 + (size_t)r * DM : (r < MTOK ? gx1 + (size_t)(r - NPROMPT) * DM : gx2 + (size_t)(r - MTOK) * DM); };
        f32x4 nv[8];
        int r = gw;
        if (r < NROW) { const f32x4* xr = (const f32x4*)src(r) + lane;
#pragma unroll
            for (int j = 0; j < 8; ++j) nv[j] = xr[64 * j]; }
        for (; r < NROW; r += NGW) {
            f32x4 v[8]; float sq = 0.f;
#pragma unroll
            for (int j = 0; j < 8; ++j) { v[j] = nv[j]; sq += (v[j].x * v[j].x + v[j].y * v[j].y) + (v[j].z * v[j].z + v[j].w * v[j].w); }
            if (r + NGW < NROW) { const f32x4* xr = (const f32x4*)src(r + NGW) + lane;
#pragma unroll
                for (int j = 0; j < 8; ++j) nv[j] = xr[64 * j]; }
            const float rstd = 1.0f / sqrtf(wave_sum(sq) * (1.f / DM) + EPS);
            const f32x4* gr = (const f32x4*)(r < MTOK ? gg0 : gg1) + lane;
            u32x2* o8 = (u32x2*)(gRB + (size_t)(r < MTOK ? r : PN_MN * 256 + (r - MTOK)) * DM) + lane;
#pragma unroll
            for (int j = 0; j < 8; ++j) { const f32x4 gq = gr[64 * j]; u32x2 w; w.x = pk_bf16(v[j].x * rstd * gq.x, v[j].y * rstd * gq.y); w.y = pk_bf16(v[j].z * rstd * gq.z, v[j].w * rstd * gq.w); o8[64 * j] = w; }
        }
    }
    for (int r = gw; r < J_WC; r += NGW) {
        const int g = r >> 9, cb = (r >> 5) & 15, nb = r & 31, n = nb * 64 + lane;
        const float* wp = a.in[13] + ((size_t)g * 128 + cb * 8) * 128; const float* sp = a.in[14] + g * 128; const float* wb = a.in[20] + (size_t)g * 128 * DM + n;
        f32x4 wq[4]; float sq[2];
#pragma unroll
        for (int k = 0; k < 4; ++k) wq[k] = ((const f32x4*)wp)[lane + 64 * k];
        sq[0] = sp[lane]; sq[1] = sp[64 + lane];
        float acc8[8];
#pragma unroll
        for (int i = 0; i < 8; ++i) acc8[i] = 0.f;
#pragma unroll
        for (int h2 = 0; h2 < 4; ++h2) {
            float xb[32];
#pragma unroll
            for (int d = 0; d < 32; ++d) xb[d] = wb[(size_t)(32 * h2 + d) * DM];
#pragma unroll
            for (int dd = 0; dd < 32; ++dd) { const int d = 32 * h2 + dd;
                const float x = xb[dd] * __int_as_float(__builtin_amdgcn_readlane(__float_as_int(sq[d >> 6]), d & 63));
#pragma unroll
                for (int i = 0; i < 8; ++i) { const int e = i * 128 + d;
                    acc8[i] += __int_as_float(__builtin_amdgcn_readlane(__float_as_int(wq[e >> 8][e & 3]), (e >> 2) & 63)) * x; } }
        }
        u32x4 o; o.x = pk_bf16(acc8[0], acc8[1]); o.y = pk_bf16(acc8[2], acc8[3]); o.z = pk_bf16(acc8[4], acc8[5]); o.w = pk_bf16(acc8[6], acc8[7]);
        *(u32x4*)(WBt + (size_t)n * DM + g * 128 + cb * 8) = o;
    }
    for (int it = NTRP + gw; it < NITEMS; it += NGW) {
        int r = it - NTRP;
        if (r < J_WC) continue;
        r -= J_WC;
        if (r < NROW) continue;
        r -= NROW;
        if (r < NKS) {
            const f32x4* s = (const f32x4*)(a.in[6] + (size_t)r * 2048) + lane; u32x2* d = (u32x2*)((bf16_t*)(ws + WS_KS) + (size_t)r * 2048) + lane;
#pragma unroll
            for (int j = 0; j < 8; ++j) { const f32x4 v = s[64 * j]; u32x2 w; w.x = pk_bf16(v.x, v.y); w.y = pk_bf16(v.z, v.w); d[64 * j] = w; }
            continue; } r -= NKS;
        {
            bf16_t* P = RB + (size_t)(PN_W + WP_ALR) * 256 * DM;
            u32x4 z = {0u, 0u, 0u, 0u}; u32x4* d = (u32x4*)(P + (size_t)(16 + r) * DM) + lane;
#pragma unroll
            for (int j = 0; j < 4; ++j) d[64 * j] = z;
            if (r < 16) { for (int k = lane; k < DM; k += 64) P[(size_t)r * DM + k] = (bf16_t)(pk_bf16(w_in[(size_t)k * INW + 3584 + r], 0.f) & 0xffffu); }
        }
    }
}

DI void pool_item(const Args& a, int item, int lane) {
    const float* U = (const float*)(a.ws + WS_U); bf16_t* BR = (bf16_t*)(a.ws + WS_BR);
    const int w = 2 << (lane >> 4), c0 = lane * 8, m0 = item * 8;
    int t0, T, seq0; const float* hist = nullptr; float* po;
    if (m0 < NPROMPT) { t0 = m0 & 4095; T = 4096; seq0 = m0 - t0; po = a.out + O_POOLP + (size_t)(m0 >> 12) * 15 * 512; }
    else { t0 = (m0 - NPROMPT) & 31; T = 32; seq0 = m0 - t0; const int b = (m0 - NPROMPT) >> 5; hist = a.in[3] + (size_t)b * 15 * 512; po = a.out + O_POOLS + (size_t)b * 15 * 512; }
    auto rowp = [&](int tt) -> const float* { return tt >= 0 ? U + (size_t)(seq0 + tt) * 512 + c0 : ((hist && tt >= -15) ? hist + (size_t)(15 + tt) * 512 + c0 : nullptr); };
    const f32x4 z4 = {0.f, 0.f, 0.f, 0.f};
    f32x4 x0[8], x1[8], y0[8], y1[8];
#pragma unroll
    for (int i = 0; i < 8; ++i) { const float* p = rowp(t0 + i); x0[i] = *(const f32x4*)p; x1[i] = *(const f32x4*)(p + 4);
        const float* q = rowp(t0 + i - w); if (q) { y0[i] = *(const f32x4*)q; y1[i] = *(const f32x4*)(q + 4); } else { y0[i] = z4; y1[i] = z4; } }
    f32x4 s0 = z4, s1 = z4;
#pragma unroll
    for (int j = 1; j <= 16; ++j) { if (j <= w) { const float* p = rowp(t0 - j); if (p) { s0 += *(const f32x4*)p; s1 += *(const f32x4*)(p + 4); } } }
#pragma unroll
    for (int i = 0; i < 8; ++i) {
        const int t = t0 + i, m = m0 + i;
        s0 += x0[i] - y0[i]; s1 += x1[i] - y1[i];
        const float cnt = hist ? (float)w : (float)((t + 1) < w ? (t + 1) : w), ic = 1.0f / cnt;
        const f32x4 d0 = s0 * ic - x0[i], d1 = s1 * ic - x1[i];
        *(u32x4*)(BR + (size_t)m * DM + c0) = pack8(d0, d1);
        if (t >= T - 15) { float* q = po + (size_t)(t - (T - 15)) * 512 + c0; *(f32x4*)q = x0[i]; *(f32x4*)(q + 4) = x1[i]; }
    }
}

DI void mem_attn_item(const Args& a, int item, int lane) {
    const int r32 = lane & 31, hh = lane >> 5;
    const bf16_t* MQ = (const bf16_t*)(a.ws + WS_MQ); bf16_t* BR = (bf16_t*)(a.ws + WS_BR);
    int m0, h; const bf16_t* Kb; const bf16_t* VT; size_t ldv;
    if (item < 2048) { const int b = item >> 9, rem = item & 511; h = rem >> 7; m0 = b * 4096 + (rem & 127) * 32;
        Kb = (const bf16_t*)(a.ws + WS_KM) + (size_t)b * 256 * 512 + h * 128; VT = (const bf16_t*)(a.ws + WS_VMT) + (size_t)h * 128 * 1024 + b * 256; ldv = 1024; }
    else { const int j = item - 2048, b = j >> 2; h = j & 3; m0 = NPROMPT + b * 32;
        Kb = (const bf16_t*)(a.ws + WS_KS) + (size_t)b * 256 * 512 + h * 128; VT = (const bf16_t*)(a.ws + WS_VST) + (size_t)h * 128 * 8192 + b * 256; ldv = 8192; }
    bf16x8 qf[8];
#pragma unroll
    for (int s = 0; s < 8; ++s) qf[s] = *(const bf16x8*)(MQ + (size_t)(m0 + r32) * 512 + h * 128 + 16 * s + 8 * hh);
    f32x16 sc[8];
    bf16x8 kA[4], kB[4];
#pragma unroll
    for (int s = 0; s < 4; ++s) kA[s] = *(const bf16x8*)(Kb + (size_t)r32 * 512 + 16 * s + 8 * hh);
    f32x16 c;
#pragma unroll
    for (int g = 0; g < 16; ++g) {
        const int kt = g >> 1, sg = g & 1;
        if (sg == 0) {
#pragma unroll
            for (int i = 0; i < 16; ++i) c[i] = 0.f; }
        if (g + 1 < 16) { const int kt1 = (g + 1) >> 1, sg1 = (g + 1) & 1;
#pragma unroll
            for (int s = 0; s < 4; ++s) { const bf16x8 v = *(const bf16x8*)(Kb + (size_t)(32 * kt1 + r32) * 512 + 16 * (4 * sg1 + s) + 8 * hh); if (g & 1) kA[s] = v; else kB[s] = v; } }
        asm volatile("" ::: "memory");
#pragma unroll
        for (int s = 0; s < 4; ++s) c = __builtin_amdgcn_mfma_f32_32x32x16_bf16((g & 1) ? kB[s] : kA[s], qf[4 * sg + s], c, 0, 0, 0);
        if (sg == 1) sc[kt] = c;
    }
    float mx = -3.0e38f;
#pragma unroll
    for (int kt = 0; kt < 8; ++kt)
#pragma unroll
        for (int i = 0; i < 16; ++i) mx = fmaxf(mx, sc[kt][i]);
    mx = fmaxf(mx, __shfl_xor(mx, 32));
    float l = 0.f;
    bf16x8 pf[8][2];
#pragma unroll
    for (int kt = 0; kt < 8; ++kt) {
        float p[16];
#pragma unroll
        for (int i = 0; i < 16; ++i) { p[i] = __builtin_amdgcn_exp2f(sc[kt][i] - mx); l += p[i]; }
#pragma unroll
        for (int s = 0; s < 2; ++s) { u32x4 w; w.x = pk_bf16(p[8 * s], p[8 * s + 1]); w.y = pk_bf16(p[8 * s + 2], p[8 * s + 3]); w.z = pk_bf16(p[8 * s + 4], p[8 * s + 5]); w.w = pk_bf16(p[8 * s + 6], p[8 * s + 7]);
            pf[kt][s] = __builtin_bit_cast(bf16x8, w); }
    }
    l += __shfl_xor(l, 32);
    const float il = 1.0f / l;
#pragma unroll
    for (int dt = 0; dt < 4; ++dt) {
        f32x16 o;
#pragma unroll
        for (int i = 0; i < 16; ++i) o[i] = 0.f;
        const bf16_t* vr = VT + (size_t)(32 * dt + r32) * ldv + 4 * hh;
#pragma unroll
        for (int kt = 0; kt < 8; ++kt)
#pragma unroll
            for (int s = 0; s < 2; ++s) {
                const s16x4 lo = *(const s16x4*)(vr + 32 * kt + 16 * s), hi = *(const s16x4*)(vr + 32 * kt + 16 * s + 8);
                const bf16x8 vf = __builtin_shufflevector(lo, hi, 0, 1, 2, 3, 4, 5, 6, 7);
                o = __builtin_amdgcn_mfma_f32_32x32x16_bf16(vf, pf[kt][s], o, 0, 0, 0);
            }
        bf16_t* op = BR + (size_t)(m0 + r32) * DM + 1536 + h * 128 + 32 * dt + 4 * hh;
#pragma unroll
        for (int g = 0; g < 4; ++g) { u32x2 w; w.x = pk_bf16(o[4 * g] * il, o[4 * g + 1] * il); w.y = pk_bf16(o[4 * g + 2] * il, o[4 * g + 3] * il); *(u32x2*)(op + 8 * g) = w; }
    }
}

constexpr int GL_QE = 0, GL_KE = 17408, GL_KT = 34816, GL_AT = 53248, GL_BL = 62464, GL_QP = 95232, GL_DEC = 97280, GL_SSQ = 97792, GL_RSTD = 99840, GL_ALR = 100096, GL_WG = 104192;
DI int crow(int reg, int hh) { return (reg & 3) + 8 * (reg >> 2) + 4 * hh; }
template <int CT>
DI void gla_sequence(const Args& a, LAS unsigned char* lds, int tok0, int nchunks, int h, const float* s_in, float* s_out) {
    const int tid = threadIdx.x, w = __builtin_amdgcn_readfirstlane(tid >> 6), lane = tid & 63, r32 = lane & 31, hh = lane >> 5;
    constexpr int QR = CT / 4, NTT = CT / 32, NKS = CT / 16;
    const bf16_t* Qg = (const bf16_t*)(a.ws + WS_Q); const bf16_t* Kg = (const bf16_t*)(a.ws + WS_K); const float* ALRg = (const float*)(a.ws + WS_ALR);
    const bf16_t* VRT = (const bf16_t*)(a.ws + WS_VRT); bf16_t* BR = (bf16_t*)(a.ws + WS_BR);
    const int vcol = h * 256 + 32 * w + r32;
    const bf16_t* vrow = VRT + (size_t)vcol * MTOK; const bf16_t* rrow = VRT + (size_t)(1024 + vcol) * MTOK;
    const float ghead = a.in[17][vcol];
    const int c1 = tid & 127, tq = tid >> 7, t2 = tid >> 3, c0 = (tid & 7) * 16;
    for (int i = tid; i < 16 * 128; i += 512) *(LAS float*)(lds + GL_WG + i * 4) = a.in[15][(size_t)(i >> 7) * 512 + h * 128 + (i & 127)];
    const float bgc = a.in[16][h * 128 + c1];
    f32x16 S[4];
#pragma unroll
    for (int kt = 0; kt < 4; ++kt)
#pragma unroll
        for (int i = 0; i < 16; ++i) S[kt][i] = s_in ? s_in[(size_t)(32 * kt + crow(i, hh)) * 256 + 32 * w + r32] : 0.f;
    f32x4 an = {0.f, 0.f, 0.f, 0.f};
    if (tid < CT * 4) { an = *(const f32x4*)(ALRg + (size_t)(tok0 + (tid >> 2)) * 16 + (tid & 3) * 4); *(LAS f32x4*)(lds + GL_ALR + tid * 16) = an; }
    LDS_WAIT(); __syncthreads();
    for (int n = 0; n < nchunks; ++n) {
        const int t0 = tok0 + n * CT;
        bf16x8 qc[2] = {}, kc[2] = {}, vf[NKS];
        if (t2 < CT) { const size_t o = (size_t)(t0 + t2) * 512 + h * 128 + c0; qc[0] = *(const bf16x8*)(Qg + o); qc[1] = *(const bf16x8*)(Qg + o + 8); kc[0] = *(const bf16x8*)(Kg + o); kc[1] = *(const bf16x8*)(Kg + o + 8); }
#pragma unroll
        for (int s = 0; s < NKS; ++s) vf[s] = *(const bf16x8*)(vrow + t0 + 16 * s + 8 * hh);
        if (n + 1 < nchunks && tid < CT * 4) an = *(const f32x4*)(ALRg + (size_t)(t0 + CT + (tid >> 2)) * 16 + (tid & 3) * 4);
        {
            float run = 0.f;
#pragma unroll 4
            for (int i = 0; i < QR; ++i) { const int t = tq * QR + i; const LAS f32x4* ar = (const LAS f32x4*)(lds + GL_ALR + t * 64);
                float pre = bgc;
#pragma unroll
                for (int j4 = 0; j4 < 4; ++j4) { const f32x4 x = ar[j4]; const LAS float* wgp = (const LAS float*)(lds + GL_WG + (4 * j4 * 128 + c1) * 4); pre += x[0] * wgp[0] + x[1] * wgp[128] + x[2] * wgp[256] + x[3] * wgp[384]; }
                const float ls = fminf(pre, 0.f) - __logf(1.0f + __expf(-fabsf(pre)));
                run += ls * (1.0f / 16.0f);
                *(LAS float*)(lds + GL_BL + (t * 128 + c1) * 4) = run; }
            *(LAS float*)(lds + GL_QP + (tq * 128 + c1) * 4) = run;
        }
        LDS_WAIT(); __syncthreads();
        if (t2 < CT) {
            const int tqr = t2 / QR;
#pragma unroll
            for (int half = 0; half < 2; ++half) {
                float bl[8], bb[8];
#pragma unroll
                for (int i = 0; i < 8; ++i) { bl[i] = 0.f; bb[i] = 0.f; }
#pragma unroll
                for (int q4 = 0; q4 < 4; ++q4) {
                    const LAS f32x4* qp = (const LAS f32x4*)(lds + GL_QP + (q4 * 128 + c0 + 8 * half) * 4); const f32x4 x0 = qp[0], x1 = qp[1];
#pragma unroll
                    for (int i = 0; i < 4; ++i) { bl[i] += x0[i]; bl[4 + i] += x1[i]; if (q4 < tqr) { bb[i] += x0[i]; bb[4 + i] += x1[i]; } }
                }
                { const LAS f32x4* bp = (const LAS f32x4*)(lds + GL_BL + (t2 * 128 + c0 + 8 * half) * 4); const f32x4 x0 = bp[0], x1 = bp[1];
#pragma unroll
                  for (int i = 0; i < 4; ++i) { bb[i] += x0[i]; bb[4 + i] += x1[i]; } }
                float qe[8], ke[8], kt[8];
#pragma unroll
                for (int i = 0; i < 8; ++i) { const float qv = bf2f((bf16_t)qc[half][i]), kv = bf2f((bf16_t)kc[half][i]);
                    qe[i] = qv * 0.08838834764831845f * __expf(bb[i]); ke[i] = kv * __expf(-bb[i]); kt[i] = kv * __expf(bl[i] - bb[i]); }
                u32x4 wq, wk; wq.x = pk_bf16(qe[0], qe[1]); wq.y = pk_bf16(qe[2], qe[3]); wq.z = pk_bf16(qe[4], qe[5]); wq.w = pk_bf16(qe[6], qe[7]);
                wk.x = pk_bf16(ke[0], ke[1]); wk.y = pk_bf16(ke[2], ke[3]); wk.z = pk_bf16(ke[4], ke[5]); wk.w = pk_bf16(ke[6], ke[7]);
                *(LAS u32x4*)(lds + GL_QE + t2 * 272 + (c0 + 8 * half) * 2) = wq;
                *(LAS u32x4*)(lds + GL_KE + t2 * 272 + (c0 + 8 * half) * 2) = wk;
#pragma unroll
                for (int i = 0; i < 8; i += 2) { const unsigned pw = pk_bf16(kt[i], kt[i + 1]);
                    *(LAS bf16_t*)(lds + GL_KT + (c0 + 8 * half + i) * 144 + t2 * 2) = (bf16_t)(pw & 0xffffu);
                    *(LAS bf16_t*)(lds + GL_KT + (c0 + 8 * half + i + 1) * 144 + t2 * 2) = (bf16_t)(pw >> 16); }
                if (t2 == CT - 1) {
#pragma unroll
                    for (int i = 0; i < 8; ++i) *(LAS float*)(lds + GL_DEC + (c0 + 8 * half + i) * 4) = __expf(bl[i]); }
            }
        }
        LDS_WAIT(); __syncthreads();
        if (w < (NTT == 2 ? 3 : 1)) {
            const int ti = (w == 0) ? 0 : 1, tj = (w == 2) ? 1 : 0;
            f32x16 c;
#pragma unroll
            for (int i = 0; i < 16; ++i) c[i] = 0.f;
#pragma unroll
            for (int s = 0; s < 8; ++s) {
                const bf16x8 af = *(const LAS bf16x8*)(lds + GL_QE + (32 * ti + r32) * 272 + (16 * s + 8 * hh) * 2);
                const bf16x8 bfr = *(const LAS bf16x8*)(lds + GL_KE + (32 * tj + r32) * 272 + (16 * s + 8 * hh) * 2);
                c = __builtin_amdgcn_mfma_f32_32x32x16_bf16(af, bfr, c, 0, 0, 0);
            }
            const int tcol = 32 * tj + r32;
#pragma unroll
            for (int i = 0; i < 16; i += 2) { const int tr0 = 32 * ti + crow(i, hh), tr1 = tr0 + 1;
                const unsigned pw = pk_bf16(tcol <= tr0 ? c[i] : 0.f, tcol <= tr1 ? c[i + 1] : 0.f);
                *(LAS bf16_t*)(lds + GL_AT + tr0 * 144 + tcol * 2) = (bf16_t)(pw & 0xffffu);
                *(LAS bf16_t*)(lds + GL_AT + tr1 * 144 + tcol * 2) = (bf16_t)(pw >> 16); }
        }
        LDS_WAIT(); __syncthreads();
        f32x16 o[NTT];
#pragma unroll
        for (int tt = 0; tt < NTT; ++tt) {
            f32x16 c;
#pragma unroll
            for (int i = 0; i < 16; ++i) c[i] = 0.f;
#pragma unroll
            for (int s = 0; s < 2 * (tt + 1); ++s) {
                const bf16x8 af = *(const LAS bf16x8*)(lds + GL_AT + (32 * tt + r32) * 144 + (16 * s + 8 * hh) * 2);
                c = __builtin_amdgcn_mfma_f32_32x32x16_bf16(af, vf[s], c, 0, 0, 0);
            }
#pragma unroll
            for (int kt = 0; kt < 4; ++kt)
#pragma unroll
                for (int s = 0; s < 2; ++s) {
                    u32x4 pw; pw.x = pk_bf16(S[kt][8 * s], S[kt][8 * s + 1]); pw.y = pk_bf16(S[kt][8 * s + 2], S[kt][8 * s + 3]); pw.z = pk_bf16(S[kt][8 * s + 4], S[kt][8 * s + 5]); pw.w = pk_bf16(S[kt][8 * s + 6], S[kt][8 * s + 7]);
                    const bf16x8 sf = __builtin_bit_cast(bf16x8, pw);
                    const LAS unsigned char* qa = lds + GL_QE + (32 * tt + r32) * 272 + (32 * kt + 16 * s + 4 * hh) * 2;
                    const s16x4 lo = *(const LAS s16x4*)qa, hi = *(const LAS s16x4*)(qa + 16);
                    const bf16x8 af = __builtin_shufflevector(lo, hi, 0, 1, 2, 3, 4, 5, 6, 7);
                    c = __builtin_amdgcn_mfma_f32_32x32x16_bf16(af, sf, c, 0, 0, 0);
                }
            o[tt] = c;
        }
#pragma unroll
        for (int tt = 0; tt < NTT; ++tt) {
            float x[16];
#pragma unroll
            for (int i = 0; i < 16; ++i) x[i] = o[tt][i] * o[tt][i];
#pragma unroll
            for (int i = 0; i < 8; ++i) { const bool up = (lane & 16) != 0; const float keep = up ? x[i + 8] : x[i], send = up ? x[i] : x[i + 8]; x[i] = keep + __shfl_xor(send, 16); }
#pragma unroll
            for (int i = 0; i < 4; ++i) { const bool up = (lane & 8) != 0; const float keep = up ? x[i + 4] : x[i], send = up ? x[i] : x[i + 4]; x[i] = keep + __shfl_xor(send, 8); }
#pragma unroll
            for (int i = 0; i < 2; ++i) { const bool up = (lane & 4) != 0; const float keep = up ? x[i + 2] : x[i], send = up ? x[i] : x[i + 2]; x[i] = keep + __shfl_xor(send, 4); }
            { const bool up = (lane & 2) != 0; const float keep = up ? x[1] : x[0], send = up ? x[0] : x[1]; x[0] = keep + __shfl_xor(send, 2); }
            x[0] += __shfl_xor(x[0], 1);
            if ((lane & 1) == 0) { const int reg = (r32 >> 1) & 15; *(LAS float*)(lds + GL_SSQ + (w * 64 + 32 * tt + crow(reg, hh)) * 4) = x[0]; }
        }
        LDS_WAIT(); __syncthreads();
        if (tid < CT) { float s = 0.f;
#pragma unroll
            for (int ww = 0; ww < 8; ++ww) s += *(const LAS float*)(lds + GL_SSQ + (ww * 64 + tid) * 4);
            *(LAS float*)(lds + GL_RSTD + tid * 4) = 1.0f / sqrtf(s * (1.0f / 256.0f) + EPS); }
        LDS_WAIT(); __syncthreads();
#pragma unroll
        for (int tt = 0; tt < NTT; ++tt)
#pragma unroll
            for (int g4 = 0; g4 < 4; ++g4) {
                const int tb = 32 * tt + 8 * g4 + 4 * hh;
                const u32x2 rw = *(const u32x2*)(rrow + t0 + tb);
                const float rv[4] = {bf_lo(rw.x), bf_hi(rw.x), bf_lo(rw.y), bf_hi(rw.y)};
#pragma unroll
                for (int e = 0; e < 4; ++e) { const float rs = *(const LAS float*)(lds + GL_RSTD + (tb + e) * 4);
                    const float val = o[tt][4 * g4 + e] * rs * ghead * rv[e];
                    BR[(size_t)(t0 + tb + e) * DM + 512 + vcol] = (bf16_t)(pk_bf16(val, 0.f) & 0xffffu); }
            }
#pragma unroll
        for (int kt = 0; kt < 4; ++kt) {
#pragma unroll
            for (int i = 0; i < 16; ++i) S[kt][i] *= *(const LAS float*)(lds + GL_DEC + (32 * kt + crow(i, hh)) * 4);
#pragma unroll
            for (int s = 0; s < NKS; ++s) {
                const bf16x8 af = *(const LAS bf16x8*)(lds + GL_KT + (32 * kt + r32) * 144 + (16 * s + 8 * hh) * 2);
                S[kt] = __builtin_amdgcn_mfma_f32_32x32x16_bf16(af, vf[s], S[kt], 0, 0, 0);
            }
        }
        if (n + 1 < nchunks && tid < CT * 4) *(LAS f32x4*)(lds + GL_ALR + tid * 16) = an;
        LDS_WAIT(); __syncthreads();
    }
#pragma unroll
    for (int kt = 0; kt < 4; ++kt)
#pragma unroll
        for (int i = 0; i < 16; ++i) s_out[(size_t)(32 * kt + crow(i, hh)) * 256 + 32 * w + r32] = S[kt][i];
}

DI void gla_prep_chunk(const Args& a, LAS unsigned char* lds, int t0, int h) {
    constexpr int CT = 64, QR = 16;
    const int tid = threadIdx.x, w = __builtin_amdgcn_readfirstlane(tid >> 6), lane = tid & 63, r32 = lane & 31, hh = lane >> 5;
    bf16_t* Qg = (bf16_t*)(a.ws + WS_Q); bf16_t* Kg = (bf16_t*)(a.ws + WS_K); const float* ALRg = (const float*)(a.ws + WS_ALR); bf16_t* BR = (bf16_t*)(a.ws + WS_BR);
    const int c1 = tid & 127, tq = tid >> 7, t2 = tid >> 3, c0 = (tid & 7) * 16;
    const float bgc = a.in[16][h * 128 + c1];
    bf16x8 qc[2], kc[2];
    { const size_t o = (size_t)(t0 + t2) * 512 + h * 128 + c0; qc[0] = *(const bf16x8*)(Qg + o); qc[1] = *(const bf16x8*)(Qg + o + 8); kc[0] = *(const bf16x8*)(Kg + o); kc[1] = *(const bf16x8*)(Kg + o + 8); }
    if (tid < CT * 4) *(LAS f32x4*)(lds + GL_ALR + tid * 16) = *(const f32x4*)(ALRg + (size_t)(t0 + (tid >> 2)) * 16 + (tid & 3) * 4);
    LDS_WAIT(); __syncthreads();
    {
        float run = 0.f;
#pragma unroll 4
        for (int i = 0; i < QR; ++i) { const int t = tq * QR + i; const LAS f32x4* ar = (const LAS f32x4*)(lds + GL_ALR + t * 64);
            float pre = bgc;
#pragma unroll
            for (int j4 = 0; j4 < 4; ++j4) { const f32x4 x = ar[j4]; const LAS float* wgp = (const LAS float*)(lds + GL_WG + (4 * j4 * 128 + c1) * 4); pre += x[0] * wgp[0] + x[1] * wgp[128] + x[2] * wgp[256] + x[3] * wgp[384]; }
            const float ls = fminf(pre, 0.f) - __logf(1.0f + __expf(-fabsf(pre)));
            run += ls * (1.0f / 16.0f);
            *(LAS float*)(lds + GL_BL + (t * 128 + c1) * 4) = run; }
        *(LAS float*)(lds + GL_QP + (tq * 128 + c1) * 4) = run;
    }
    LDS_WAIT(); __syncthreads();
    {
        const int tqr = t2 / QR;
#pragma unroll
        for (int half = 0; half < 2; ++half) {
            float bl[8], bb[8];
#pragma unroll
            for (int i = 0; i < 8; ++i) { bl[i] = 0.f; bb[i] = 0.f; }
#pragma unroll
            for (int q4 = 0; q4 < 4; ++q4) {
                const LAS f32x4* qp = (const LAS f32x4*)(lds + GL_QP + (q4 * 128 + c0 + 8 * half) * 4); const f32x4 x0 = qp[0], x1 = qp[1];
#pragma unroll
                for (int i = 0; i < 4; ++i) { bl[i] += x0[i]; bl[4 + i] += x1[i]; if (q4 < tqr) { bb[i] += x0[i]; bb[4 + i] += x1[i]; } }
            }
            { const LAS f32x4* bp = (const LAS f32x4*)(lds + GL_BL + (t2 * 128 + c0 + 8 * half) * 4); const f32x4 x0 = bp[0], x1 = bp[1];
#pragma unroll
              for (int i = 0; i < 4; ++i) { bb[i] += x0[i]; bb[4 + i] += x1[i]; } }
            float qe[8], ke[8], kt[8];
#pragma unroll
            for (int i = 0; i < 8; ++i) { const float qv = bf2f((bf16_t)qc[half][i]), kv = bf2f((bf16_t)kc[half][i]);
                qe[i] = qv * 0.08838834764831845f * __expf(bb[i]); ke[i] = kv * __expf(-bb[i]); kt[i] = kv * __expf(bl[i] - bb[i]); }
            u32x4 wq, wk; wq.x = pk_bf16(qe[0], qe[1]); wq.y = pk_bf16(qe[2], qe[3]); wq.z = pk_bf16(qe[4], qe[5]); wq.w = pk_bf16(qe[6], qe[7]);
            wk.x = pk_bf16(ke[0], ke[1]); wk.y = pk_bf16(ke[2], ke[3]); wk.z = pk_bf16(ke[4], ke[5]); wk.w = pk_bf16(ke[6], ke[7]);
            *(LAS u32x4*)(lds + GL_QE + t2 * 272 + (c0 + 8 * half) * 2) = wq;
            *(LAS u32x4*)(lds + GL_KE + t2 * 272 + (c0 + 8 * half) * 2) = wk;
            *(u32x4*)(Qg + (size_t)(t0 + t2) * 512 + h * 128 + c0 + 8 * half) = wq;
#pragma unroll
            for (int i = 0; i < 8; i += 2) { const unsigned pw = pk_bf16(kt[i], kt[i + 1]);
                *(LAS bf16_t*)(lds + GL_KT + (c0 + 8 * half + i) * 144 + t2 * 2) = (bf16_t)(pw & 0xffffu);
                *(LAS bf16_t*)(lds + GL_KT + (c0 + 8 * half + i + 1) * 144 + t2 * 2) = (bf16_t)(pw >> 16); }
            if (t2 == CT - 1) {
                f32x4 d0, d1;
#pragma unroll
                for (int i = 0; i < 4; ++i) { d0[i] = __expf(bl[i]); d1[i] = __expf(bl[4 + i]); }
                const int c = c0 + 8 * half; float* dp = (float*)(BR + (size_t)(t0 + (c >> 5)) * DM + 512 + h * 256 + 64) + (c & 31);
                *(f32x4*)dp = d0; *(f32x4*)(dp + 4) = d1; }
        }
    }
    LDS_WAIT(); __syncthreads();
#pragma unroll
    for (int i = 0; i < 2; ++i) { const int x = tid + 512 * i, c = x >> 3, j = x & 7;
        const u32x4 v = *(const LAS u32x4*)(lds + GL_KT + c * 144 + j * 16);
        *(u32x4*)(Kg + (size_t)(t0 + (c >> 1)) * 512 + h * 128 + (c & 1) * 64 + j * 8) = v; }
    if (w < 3) {
        const int ti = (w == 0) ? 0 : 1, tj = (w == 2) ? 1 : 0;
        f32x16 c;
#pragma unroll
        for (int i = 0; i < 16; ++i) c[i] = 0.f;
#pragma unroll
        for (int s = 0; s < 8; ++s) {
            const bf16x8 af = *(const LAS bf16x8*)(lds + GL_QE + (32 * ti + r32) * 272 + (16 * s + 8 * hh) * 2);
            const bf16x8 bfr = *(const LAS bf16x8*)(lds + GL_KE + (32 * tj + r32) * 272 + (16 * s + 8 * hh) * 2);
            c = __builtin_amdgcn_mfma_f32_32x32x16_bf16(af, bfr, c, 0, 0, 0);
        }
        const int tcol = 32 * tj + r32;
#pragma unroll
        for (int i = 0; i < 16; i += 2) { const int tr0 = 32 * ti + crow(i, hh), tr1 = tr0 + 1;
            const unsigned pw = pk_bf16(tcol <= tr0 ? c[i] : 0.f, tcol <= tr1 ? c[i + 1] : 0.f);
            *(LAS bf16_t*)(lds + GL_AT + tr0 * 144 + tcol * 2) = (bf16_t)(pw & 0xffffu);
            *(LAS bf16_t*)(lds + GL_AT + tr1 * 144 + tcol * 2) = (bf16_t)(pw >> 16); }
    }
    LDS_WAIT(); __syncthreads();
    { const int t = tid >> 3, j = tid & 7; const u32x4 v = *(const LAS u32x4*)(lds + GL_AT + t * 144 + j * 16);
      *(u32x4*)(BR + (size_t)(t0 + t) * DM + 512 + h * 256 + j * 8) = v; }
}

constexpr int GB_IMG = 41984, GB_KT = 16384, GB_AT = 32768, GB_DEC = 40960, GB_SSQ = 2 * GB_IMG, GB_OST = GB_SSQ + 4096, GB_RST = GB_OST + 32768;
constexpr int GLA_SEGS = 8, GLA_SEG_CH = 8, GLA_NAGG = GLA_SEGS - 1;
template <int MODE>
DI void gla_scan(const Args& a, LAS unsigned char* lds, int b, int h, int seg, float* s_out) {
    const int tid = threadIdx.x, w = __builtin_amdgcn_readfirstlane(tid >> 6), lane = tid & 63, r32 = lane & 31, hh = lane >> 5;
    const bf16_t* Qg = (const bf16_t*)(a.ws + WS_Q); const bf16_t* Kg = (const bf16_t*)(a.ws + WS_K); const bf16_t* VRT = (const bf16_t*)(a.ws + WS_VRT); bf16_t* BR = (bf16_t*)(a.ws + WS_BR);
    float* AGG = (float*)(a.ws + WS_AGG); float* DCUM = (float*)(a.ws + WS_DCUM);
    const int vcol = h * 256 + 32 * w + r32, tok0 = b * 4096 + seg * GLA_SEG_CH * 64, bh = b * 4 + h;
    const bf16_t* vrow = VRT + (size_t)vcol * MTOK; const bf16_t* rrow = VRT + (size_t)(1024 + vcol) * MTOK;
    const float ghead = a.in[17][vcol];
    auto stage = [&](int n) { const int t0 = tok0 + 64 * n; LAS unsigned char* img = lds + (n & 1) * GB_IMG;
        int tl = threadIdx.x; asm volatile("" : "+v"(tl));
        unsigned soQ[2], soA, soD;
#pragma unroll
        for (int i = 0; i < 2; ++i) { const int p = tl + 512 * i, R = p >> 4, q = (p & 15) ^ (R & 15); soQ[i] = (unsigned)(R * 512 + h * 128 + q * 8); }
        { const int p = tl, R = p >> 4, q = (p & 15) ^ (R & 15), t = 2 * R + (q >> 3), j = q & 7; soA = (unsigned)(t * DM + 512 + h * 256 + j * 8); }
        { const int p = tl & 31; soD = (unsigned)((p >> 3) * DM + 512 + h * 256 + 64 + (p & 7) * 8); }
#pragma unroll
        for (int i = 0; i < 2; ++i) {
            if (MODE == 1) __builtin_amdgcn_global_load_lds((const unsigned*)(Qg + (size_t)t0 * 512 + soQ[i]), (LAS unsigned*)(img + (512 * i + 64 * w) * 16), 16, 0, 0);
            __builtin_amdgcn_global_load_lds((const unsigned*)(Kg + (size_t)t0 * 512 + soQ[i]), (LAS unsigned*)(img + GB_KT + (512 * i + 64 * w) * 16), 16, 0, 0); }
        if (MODE == 1) __builtin_amdgcn_global_load_lds((const unsigned*)(BR + (size_t)t0 * DM + soA), (LAS unsigned*)(img + GB_AT + (64 * w) * 16), 16, 0, 0);
        if (w == 0 && lane < 32) __builtin_amdgcn_global_load_lds((const unsigned*)(BR + (size_t)t0 * DM + soD), (LAS unsigned*)(img + GB_DEC), 16, 0, 0); };
    bf16x8 vf[4];
#pragma unroll
    for (int s = 0; s < 4; ++s) vf[s] = *(const bf16x8*)(vrow + tok0 + 16 * s + 8 * hh);
    stage(0);
    f32x16 S[4];
#pragma unroll
    for (int kt = 0; kt < 4; ++kt)
#pragma unroll
        for (int i = 0; i < 16; ++i) S[kt][i] = 0.f;
    if (MODE == 1) {
        for (int j = 0; j < seg; ++j) { const float* ag = AGG + ((size_t)((bh * GLA_NAGG + j) * 8 + w) * 64) * 64 + lane; const float* dc = DCUM + (size_t)(bh * GLA_NAGG + j) * 128;
#pragma unroll
            for (int kt = 0; kt < 4; ++kt)
#pragma unroll
                for (int g = 0; g < 4; ++g) { const f32x4 d = *(const f32x4*)(dc + 32 * kt + 8 * g + 4 * hh);
#pragma unroll
                    for (int e = 0; e < 4; ++e) S[kt][4 * g + e] = S[kt][4 * g + e] * d[e] + ag[(size_t)(kt * 16 + 4 * g + e) * 64]; } }
    }
    float dprod = 1.0f;
    for (int n = 0; n < GLA_SEG_CH; ++n) {
        const int t0 = tok0 + 64 * n; const LAS unsigned char* img = lds + (n & 1) * GB_IMG;
        asm volatile("s_waitcnt vmcnt(0) lgkmcnt(0)" ::: "memory"); __builtin_amdgcn_s_barrier(); asm volatile("" ::: "memory");
        if (n + 1 < GLA_SEG_CH) stage(n + 1);
        bf16x8 vn[4];
        u32x2 rw[8];
        f32x16 op[2];
        if (MODE == 1) {
#pragma unroll
            for (int tt = 0; tt < 2; ++tt) {
                f32x16 c;
#pragma unroll
                for (int i = 0; i < 16; ++i) c[i] = 0.f;
                const int t = 32 * tt + r32;
#pragma unroll
                for (int s = 0; s < 2 * (tt + 1); ++s) { const int R = t >> 1, q = (t & 1) * 8 + 2 * s + hh;
                    const bf16x8 af = *(const LAS bf16x8*)(img + GB_AT + R * 256 + ((q ^ (R & 15)) * 16));
                    c = __builtin_amdgcn_mfma_f32_32x32x16_bf16(af, vf[s], c, 0, 0, 0); }
#pragma unroll
                for (int kt = 0; kt < 4; ++kt)
#pragma unroll
                    for (int s = 0; s < 2; ++s) {
                        u32x4 pw; pw.x = pk_bf16(S[kt][8 * s], S[kt][8 * s + 1]); pw.y = pk_bf16(S[kt][8 * s + 2], S[kt][8 * s + 3]); pw.z = pk_bf16(S[kt][8 * s + 4], S[kt][8 * s + 5]); pw.w = pk_bf16(S[kt][8 * s + 6], S[kt][8 * s + 7]);
                        const bf16x8 sf = __builtin_bit_cast(bf16x8, pw);
                        const int q0 = 4 * kt + 2 * s;
                        const LAS unsigned char* rowp = img + t * 256 + 8 * hh;
                        const s16x4 lo = *(const LAS s16x4*)(rowp + ((q0 ^ (t & 15)) * 16)), hi = *(const LAS s16x4*)(rowp + (((q0 + 1) ^ (t & 15)) * 16));
                        const bf16x8 af = __builtin_shufflevector(lo, hi, 0, 1, 2, 3, 4, 5, 6, 7);
                        c = __builtin_amdgcn_mfma_f32_32x32x16_bf16(af, sf, c, 0, 0, 0);
                        if (s == 1) asm volatile("" ::: "memory");
                    }
                op[tt] = c;
            }
#pragma unroll
            for (int tt = 0; tt < 2; ++tt) {
                float x[16];
#pragma unroll
                for (int i = 0; i < 16; ++i) x[i] = op[tt][i] * op[tt][i];
#pragma unroll
                for (int i = 0; i < 8; ++i) { const bool up = (lane & 16) != 0; const float keep = up ? x[i + 8] : x[i], send = up ? x[i] : x[i + 8]; x[i] = keep + __shfl_xor(send, 16); }
#pragma unroll
                for (int i = 0; i < 4; ++i) { const bool up = (lane & 8) != 0; const float keep = up ? x[i + 4] : x[i], send = up ? x[i] : x[i + 4]; x[i] = keep + __shfl_xor(send, 8); }
#pragma unroll
                for (int i = 0; i < 2; ++i) { const bool up = (lane & 4) != 0; const float keep = up ? x[i + 2] : x[i], send = up ? x[i] : x[i + 2]; x[i] = keep + __shfl_xor(send, 4); }
                { const bool up = (lane & 2) != 0; const float keep = up ? x[1] : x[0], send = up ? x[0] : x[1]; x[0] = keep + __shfl_xor(send, 2); }
                x[0] += __shfl_xor(x[0], 1);
                if ((lane & 1) == 0) { const int reg = (r32 >> 1) & 15; *(LAS float*)(lds + GB_SSQ + (n & 1) * 2048 + (32 * tt + crow(reg, hh)) * 32 + w * 4) = x[0]; }
            }
        } else { if (tid < 128) dprod *= *(const LAS float*)(img + GB_DEC + tid * 4); }
#pragma unroll
        for (int s = 0; s < 4; ++s) vn[s] = (n + 1 < GLA_SEG_CH) ? *(const bf16x8*)(vrow + t0 + 64 + 16 * s + 8 * hh) : vf[s];
        if (MODE == 1) {
#pragma unroll
            for (int i = 0; i < 8; ++i) rw[i] = *(const u32x2*)(rrow + t0 + 32 * (i >> 2) + 8 * (i & 3) + 4 * hh); }
#pragma unroll
        for (int kt = 0; kt < 4; ++kt) {
#pragma unroll
            for (int g = 0; g < 4; ++g) { const f32x4 d = *(const LAS f32x4*)(img + GB_DEC + (32 * kt + 8 * g + 4 * hh) * 4);
#pragma unroll
                for (int e = 0; e < 4; ++e) S[kt][4 * g + e] *= d[e]; }
            const int c = 32 * kt + r32, R = c >> 1;
#pragma unroll
            for (int s = 0; s < 4; ++s) { const int q = (c & 1) * 8 + 2 * s + hh;
                const bf16x8 af = *(const LAS bf16x8*)(img + GB_KT + R * 256 + ((q ^ (R & 15)) * 16));
                S[kt] = __builtin_amdgcn_mfma_f32_32x32x16_bf16(af, vf[s], S[kt], 0, 0, 0); }
            asm volatile("" ::: "memory");
        }
        if (MODE == 1) {
            asm volatile("s_waitcnt lgkmcnt(0)" ::: "memory"); __builtin_amdgcn_s_barrier(); asm volatile("" ::: "memory");
            LAS unsigned char* ost = lds + GB_OST + w * 4096; const LAS unsigned char* sq = lds + GB_SSQ + (n & 1) * 2048; LAS unsigned char* rsw = lds + GB_RST + w * 256;
            { const LAS f32x4* sp = (const LAS f32x4*)(sq + lane * 32); const f32x4 s0 = sp[0], s1 = sp[1];
              const float ss = ((s0[0] + s0[1]) + (s0[2] + s0[3])) + ((s1[0] + s1[1]) + (s1[2] + s1[3]));
              *(LAS float*)(rsw + lane * 4) = 1.0f / sqrtf(ss * (1.0f / 256.0f) + EPS); }
            LDS_WAIT();
#pragma unroll
            for (int tt = 0; tt < 2; ++tt)
#pragma unroll
                for (int g4 = 0; g4 < 4; ++g4) {
                    const int tb = 32 * tt + 8 * g4 + 4 * hh; const u32x2 r2 = rw[tt * 4 + g4];
                    const float rv[4] = {bf_lo(r2.x), bf_hi(r2.x), bf_lo(r2.y), bf_hi(r2.y)};
                    const f32x4 rs4 = *(const LAS f32x4*)(rsw + tb * 4);
#pragma unroll
                    for (int e = 0; e < 4; ++e) { const float val = op[tt][4 * g4 + e] * rs4[e] * ghead * rv[e];
                        *(LAS bf16_t*)(ost + (tb + e) * 64 + r32 * 2) = (bf16_t)(pk_bf16(val, 0.f) & 0xffffu); }
                }
            LDS_WAIT();
#pragma unroll
            for (int i = 0; i < 4; ++i) { const int x = lane + 64 * i, t = x >> 2, part = x & 3; const u32x4 v = *(const LAS u32x4*)(ost + t * 64 + part * 16);
                *(u32x4*)(BR + (size_t)(t0 + t) * DM + 512 + h * 256 + 32 * w + part * 8) = v; }
        }
#pragma unroll
        for (int s = 0; s < 4; ++s) vf[s] = vn[s];
    }
    if (MODE == 1) {
        if (seg == GLA_SEGS - 1) {
#pragma unroll
            for (int kt = 0; kt < 4; ++kt)
#pragma unroll
                for (int i = 0; i < 16; ++i) s_out[(size_t)(32 * kt + crow(i, hh)) * 256 + 32 * w + r32] = S[kt][i]; }
    } else {
        float* ag = AGG + ((size_t)((bh * GLA_NAGG + seg) * 8 + w) * 64) * 64 + lane;
#pragma unroll
        for (int kt = 0; kt < 4; ++kt)
#pragma unroll
            for (int i = 0; i < 16; ++i) ag[(size_t)(kt * 16 + i) * 64] = S[kt][i];
        if (tid < 128) DCUM[(size_t)(bh * GLA_NAGG + seg) * 128 + tid] = dprod;
    }
}

DI void p5_rows(const Args& a, int gw, int NGW, int lane) {
    const bf16_t* Y2 = (const bf16_t*)(a.ws + WS_Y2); const float* SQ = (const float*)(a.ws + WS_SSQ); bf16_t* H2 = (bf16_t*)(a.ws + WS_H2);
    f32x4 ax[8], bx_[8]; u32x2 ay[8], by[8]; float aq = 0.f, bq = 0.f;
    auto issueA = [&](int m) { const float* xr = (m < NPROMPT) ? a.in[0] + (size_t)m * DM : a.in[1] + (size_t)(m - NPROMPT) * DM; const bf16_t* yr = Y2 + (size_t)m * DM;
#pragma unroll
        for (int j = 0; j < 8; ++j) { ax[j] = ((const f32x4*)xr)[lane + 64 * j]; ay[j] = ((const u32x2*)yr)[lane + 64 * j]; }
        aq = (lane < 32) ? SQ[(size_t)m * 32 + lane] : 0.f; };
    auto issueB = [&](int m) { const float* xr = (m < NPROMPT) ? a.in[0] + (size_t)m * DM : a.in[1] + (size_t)(m - NPROMPT) * DM; const bf16_t* yr = Y2 + (size_t)m * DM;
#pragma unroll
        for (int j = 0; j < 8; ++j) { bx_[j] = ((const f32x4*)xr)[lane + 64 * j]; by[j] = ((const u32x2*)yr)[lane + 64 * j]; }
        bq = (lane < 32) ? SQ[(size_t)m * 32 + lane] : 0.f; };
    auto sample_row = [&](int m, f32x4 (&yv)[8]) -> float { const float* pr = (const float*)(a.ws + WS_PART) + (size_t)(m - NPROMPT) * DM; float q = 0.f;
#pragma unroll
        for (int j = 0; j < 8; ++j) { f32x4 t = ((const f32x4*)pr)[lane + 64 * j];
#pragma unroll
            for (int k = 1; k < 4; ++k) t += ((const f32x4*)(pr + (size_t)k * 1024 * DM))[lane + 64 * j];
            yv[j] = t; q += (t.x * t.x + t.y * t.y) + (t.z * t.z + t.w * t.w); }
        return q; };
    auto row = [&](int m, f32x4 (&xv)[8], f32x4 (&yv)[8], float q) {
        if (m >= NPROMPT) q = sample_row(m, yv);
        float* orow = a.out + O_Y + (size_t)m * DM; bf16_t* hr = H2 + (size_t)m * DM;
        const float rstd = 1.0f / sqrtf(wave_sum(q) * (1.f / DM) + EPS);
        float s2 = 0.f;
#pragma unroll
        for (int j = 0; j < 8; ++j) { const f32x4 gg = ((const f32x4*)a.in[24])[lane + 64 * j]; f32x4 t;
            t.x = xv[j].x + yv[j].x * rstd * gg.x; t.y = xv[j].y + yv[j].y * rstd * gg.y; t.z = xv[j].z + yv[j].z * rstd * gg.z; t.w = xv[j].w + yv[j].w * rstd * gg.w;
            xv[j] = t; ((f32x4*)orow)[lane + 64 * j] = t; s2 += (t.x * t.x + t.y * t.y) + (t.z * t.z + t.w * t.w); }
        const float rstd2 = 1.0f / sqrtf(wave_sum(s2) * (1.f / DM) + EPS);
#pragma unroll
        for (int j = 0; j < 8; ++j) { const f32x4 gg = ((const f32x4*)a.in[25])[lane + 64 * j]; u32x2 w; w.x = pk_bf16(xv[j].x * rstd2 * gg.x, xv[j].y * rstd2 * gg.y); w.y = pk_bf16(xv[j].z * rstd2 * gg.z, xv[j].w * rstd2 * gg.w);
            ((u32x2*)hr)[lane + 64 * j] = w; } };
    int m = gw;
    if (m < MTOK) issueA(m);
    if (m + NGW < MTOK) issueB(m + NGW);
    for (; m < MTOK; m += 2 * NGW) {
        { f32x4 xv[8], yv[8]; const float q = aq;
#pragma unroll
          for (int j = 0; j < 8; ++j) { xv[j] = ax[j]; yv[j] = (f32x4){bf_lo(ay[j].x), bf_hi(ay[j].x), bf_lo(ay[j].y), bf_hi(ay[j].y)}; }
          if (m + 2 * NGW < MTOK) issueA(m + 2 * NGW);
          row(m, xv, yv, q); }
        if (m + NGW < MTOK) { f32x4 xv[8], yv[8]; const float q = bq;
#pragma unroll
          for (int j = 0; j < 8; ++j) { xv[j] = bx_[j]; yv[j] = (f32x4){bf_lo(by[j].x), bf_hi(by[j].x), bf_lo(by[j].y), bf_hi(by[j].y)}; }
          if (m + 3 * NGW < MTOK) issueB(m + 3 * NGW);
          row(m + NGW, xv, yv, q); }
    }
}
DI void p9_rows(const Args& a, int gw, int NGW, int lane) {
    const bf16_t* Fb = (const bf16_t*)(a.ws + WS_F); const float* SQ = (const float*)(a.ws + WS_SSQ2);
    f32x4 nx[8]; u32x2 ny[8]; float nq = 0.f;
    auto issue = [&](int m) { const float* xr = a.out + O_Y + (size_t)m * DM; const bf16_t* yr = Fb + (size_t)m * DM;
#pragma unroll
        for (int j = 0; j < 8; ++j) { nx[j] = ((const f32x4*)xr)[lane + 64 * j]; ny[j] = ((const u32x2*)yr)[lane + 64 * j]; }
        nq = (lane < 32) ? SQ[(size_t)m * 32 + lane] : 0.f; };
    auto sample_row = [&](int m, f32x4 (&yv)[8]) -> float { const float* pr = (const float*)(a.ws + WS_PART2) + (size_t)(m - NPROMPT) * DM; float q = 0.f;
#pragma unroll
        for (int j = 0; j < 8; ++j) { f32x4 t = ((const f32x4*)pr)[lane + 64 * j];
#pragma unroll
            for (int k = 1; k < 2; ++k) t += ((const f32x4*)(pr + (size_t)k * 1024 * DM))[lane + 64 * j];
            yv[j] = t; q += (t.x * t.x + t.y * t.y) + (t.z * t.z + t.w * t.w); }
        return q; };
    int m = gw; if (m < MTOK) issue(m);
    for (; m < MTOK; m += NGW) {
        f32x4 xv[8]; f32x4 yv[8]; float q = nq;
#pragma unroll
        for (int j = 0; j < 8; ++j) { xv[j] = nx[j]; yv[j] = (f32x4){bf_lo(ny[j].x), bf_hi(ny[j].x), bf_lo(ny[j].y), bf_hi(ny[j].y)}; }
        if (m >= NPROMPT) q = sample_row(m, yv);
        if (m + NGW < MTOK) issue(m + NGW);
        float* orow = a.out + O_Y + (size_t)m * DM;
        const float rstd = 1.0f / sqrtf(wave_sum(q) * (1.f / DM) + EPS);
#pragma unroll
        for (int j = 0; j < 8; ++j) { const f32x4 gg = ((const f32x4*)a.in[30])[lane + 64 * j]; f32x4 t;
            t.x = xv[j].x + yv[j].x * rstd * gg.x; t.y = xv[j].y + yv[j].y * rstd * gg.y; t.z = xv[j].z + yv[j].z * rstd * gg.z; t.w = xv[j].w + yv[j].w * rstd * gg.w;
            ((f32x4*)orow)[lane + 64 * j] = t; }
    }
}
DI float gelu_tanh(float x) { const float z = 1.5957691216057308f * (x + 0.044715f * x * x * x); return x * __builtin_amdgcn_rcpf(1.0f + __expf(-z)); }
DI void seam_rows(const Args& a, int pm) {
    const float* HEAD = (const float*)(a.ws + WS_HEAD) + (size_t)pm * 2 * F2; const float* TAIL = (const float*)(a.ws + WS_TAIL) + (size_t)(pm - 1) * 2 * F2;
    const float* wdw = a.in[27]; const float* bdw = a.in[28]; bf16_t* HG = (bf16_t*)(a.ws + WS_HG) + (size_t)pm * 256 * FF;
    for (int i = threadIdx.x; i < 2 * FF; i += 512) { const int r = i / FF, f = i - r * FF;
        float cg = bdw[f], cv = bdw[FF + f];
        const float* a0 = HEAD + (size_t)r * F2; const float* a1 = r ? HEAD : TAIL + F2; const float* a2 = r ? TAIL + F2 : TAIL;
        cg += wdw[f] * a2[f] + wdw[F2 + f] * a1[f] + wdw[2 * F2 + f] * a0[f];
        cv += wdw[FF + f] * a2[FF + f] + wdw[F2 + FF + f] * a1[FF + f] + wdw[2 * F2 + FF + f] * a0[FF + f];
        HG[(size_t)r * FF + f] = (bf16_t)(pk_bf16(gelu_tanh(cg) * cv, 0.f) & 0xffffu); }
}

constexpr int WCOPY_WO = 2048, WCOPY_UP = WCOPY_WO + 32 * 352, WCOPY_N = WCOPY_UP + 88 * 64, WCOPY_T1 = 3456;
DI void wcopy_items(const Args& a, LAS unsigned char* lds, int i0, int i1, int g, int NG, int wave, int lane) {
    LAS float* scr = (LAS float*)(lds + wave * 16384);
    const float* w_o = as_global(a.in[23]); const float* w_up = as_global(a.in[26]); const float* w_dn = as_global(a.in[29]); unsigned char* ws = as_global(a.ws);
    tr_pipeline([=](int it) -> TrSrc { TrSrc t;
        if (it < WCOPY_WO) { const int kb = it / 64, n0 = (it % 64) * 32; t.src = w_o + (size_t)(kb * 64) * 2048 + n0; t.ldw = 2048; t.dst = (bf16_t*)(ws + WS_WO) + (size_t)n0 * DM + kb * 64; t.dld = DM; }
        else if (it < WCOPY_UP) { const int r = it - WCOPY_WO, kb = r / 352, n0 = (r % 352) * 32; const int part = n0 / FF, jf = n0 % FF, rho = (jf >> 7) * 256 + part * 128 + (jf & 127);
            t.src = w_up + (size_t)(kb * 64) * F2 + n0; t.ldw = F2; t.dst = (bf16_t*)(ws + WS_WUP) + (size_t)rho * DM + kb * 64; t.dld = DM; }
        else { const int r = it - WCOPY_UP, kb = r / 64, n0 = (r % 64) * 32; t.src = w_dn + (size_t)(kb * 64) * 2048 + n0; t.ldw = 2048; t.dst = (bf16_t*)(ws + WS_WDN) + (size_t)n0 * FF + kb * 64; t.dld = FF; }
        return t; }, i0, i1, g, NG, scr, lane);
}

constexpr int PH_P0 = 0, PH_P1 = 1, PH_P2A = 2, PH_P2B = 3, PH_P2C = 4, PH_MERGE = 5, PH_WO = 6, PH_NORM1 = 7, PH_UP = 8, PH_DOWN = 9, PH_FINAL = 10, NPH = 11;
__global__ void __launch_bounds__(512, 2) fwd_kernel(Args args_unused) {
    extern __shared__ __attribute__((aligned(16))) unsigned char lds_raw[];
    LAS unsigned char* lds = (LAS unsigned char*)lds_raw;
    { const unsigned* kp = (const unsigned*)__builtin_amdgcn_kernarg_segment_ptr(); if (threadIdx.x < ARGS_DW) ((LAS unsigned*)(lds + LDSARGS_OFF))[threadIdx.x] = kp[threadIdx.x]; }
    volatile LAS unsigned* MISC = (volatile LAS unsigned*)(lds + MISC_OFF);
    const int tid = threadIdx.x, lane = tid & 63, wave = __builtin_amdgcn_readfirstlane(tid >> 6);
    const int G = gridDim.x, bx = blockIdx.x, vcu = (G % 8 == 0) ? (bx % 8) * (G / 8) + bx / 8 : bx;
    const int gw = vcu * 8 + wave, NGW = G * 8;
    for (int u = tid; u < (MISC_OFF + 128 - LDSCTL_OFF) / 4; u += 512) ((LAS unsigned*)(lds + LDSCTL_OFF))[u] = 0u;
    __syncthreads();
    int lo, hi, li; unsigned char* ws0;
    { const Args a0 = fetch_args(lds); lo = a0.ph_lo; hi = a0.ph_hi; li = a0.li; ws0 = a0.ws; }
    const bool multi = (hi - lo) > 1;
    XcdBarrier bar; bar.bar = (unsigned*)(ws0 + WS_CTL) + CW_BAR + li * XCD_BAR_WORDS; bar.x = 0; bar.st = nullptr;
    if (multi) bar = xcd_barrier_post((unsigned*)(ws0 + WS_CTL) + CW_BAR + li * XCD_BAR_WORDS, MISC + 8);
#define IN(k) (lo <= (k) && (k) < hi)
#define SEAM(k) do { if (IN(k) && IN((k) + 1)) xcd_barrier(bar); } while (0)

    if (IN(PH_P0)) { const Args args = fetch_args<((GMASK >> PH_P0) & 1) != 0>(lds); p0_prologue(args, lds, gw, NGW, wave, lane); }
    SEAM(PH_P0);
    if (IN(PH_P1)) {
        const Args args = fetch_args<((GMASK >> PH_P1) & 1) != 0>(lds); unsigned char* ws = args.ws; bf16_t* RB = (bf16_t*)(ws + WS_RB);
        pg8::Gemm g{RB, RB, DM, DM, DM}; pg8::SchedP1 S{G, bx};
        pg8::EpiP1 E{ws, args.out, args.in[19]};
        pg8::gemm_phase<pg8::EpiP1, pg8::SchedP1>(lds, g, S, E);
    }
    SEAM(PH_P1);
    if (IN(PH_P2A)) {
        const Args args = fetch_args<((GMASK >> PH_P2A) & 1) != 0>(lds); const int h = bx & 3;
        for (int i = tid; i < 16 * 128; i += 512) *(LAS float*)(lds + GL_WG + i * 4) = args.in[15][(size_t)(i >> 7) * 512 + h * 128 + (i & 127)];
        for (int bn = (bx >> 2); bn < 256; bn += (G >> 2)) { gla_prep_chunk(args, lds, (bn >> 6) * 4096 + (bn & 63) * 64, h); }
        constexpr int N_MA = 2048, N_PL = MTOK / 8;
        for (int it = gw; it < N_MA + N_PL; it += NGW) { if (it < N_MA) mem_attn_item(args, it, lane); else pool_item(args, it - N_MA, lane); }
    }
    SEAM(PH_P2A);
    if (IN(PH_P2B)) {
        const Args args = fetch_args<((GMASK >> PH_P2B) & 1) != 0>(lds);
        if (bx < 16 * GLA_NAGG) { gla_scan<0>(args, lds, (bx >> 2) & 3, bx & 3, bx >> 4, nullptr); }
        else {
            if (bx < 240) { const int it = bx - 112; gla_sequence<32>(args, lds, NPROMPT + (it >> 2) * 32, 1, it & 3, args.in[4] + (size_t)it * 128 * 256, args.out + O_GLAS + (size_t)it * 128 * 256); __syncthreads(); }
            if (bx >= 240) { const int it = (bx - 240) * 8 + wave; if (it < 128) mem_attn_item(args, 2048 + it, lane); }
            wcopy_items(args, lds, 0, WCOPY_T1, (bx - 112) * 8 + wave, (G - 112) * 8, wave, lane);
        }
    }
    SEAM(PH_P2B);
    if (IN(PH_P2C)) {
        const Args args = fetch_args<((GMASK >> PH_P2C) & 1) != 0>(lds); unsigned char* ws = args.ws;
        if (bx < 16 * GLA_SEGS) { const int bh = bx & 15; gla_scan<1>(args, lds, bh >> 2, bh & 3, bx >> 4, args.out + O_GLAP + (size_t)bh * 128 * 256); }
        else if (bx < 160) {
            pg8::Gemm g{(const bf16_t*)(ws + WS_BR), (const bf16_t*)(ws + WS_WB), DM, DM, DM}; pg8::SchedOne S{64 + ((bx - 128) >> 3), (bx - 128) & 7, 32};
            pg8::EpiMerge E{ws};
            pg8::gemm_phase<pg8::EpiMerge, pg8::SchedOne>(lds, g, S, E);
        }
        else wcopy_items(args, lds, WCOPY_T1, WCOPY_N, (bx - 160) * 8 + wave, (G - 160) * 8, wave, lane);
    }
    SEAM(PH_P2C);
    if (IN(PH_MERGE)) {
        const Args args = fetch_args<((GMASK >> PH_MERGE) & 1) != 0>(lds); unsigned char* ws = args.ws;
        pg8::Gemm g{(const bf16_t*)(ws + WS_BR), (const bf16_t*)(ws + WS_WB), DM, DM, DM}; pg8::Sched2D S{64, 8, G, bx, 0, 0, 32};
        pg8::EpiMerge E{ws};
        pg8::gemm_phase<pg8::EpiMerge, pg8::Sched2D>(lds, g, S, E);
    }
    SEAM(PH_MERGE);
    if (IN(PH_WO)) {
        const Args args = fetch_args<((GMASK >> PH_WO) & 1) != 0>(lds); unsigned char* ws = args.ws;
        pg8::Gemm g{(const bf16_t*)(ws + WS_MG), (const bf16_t*)(ws + WS_WO), DM, DM, DM}; pg8::SchedTail S{G, bx, 32, 128};
        pg8::EpiNorm E{(bf16_t*)(ws + WS_Y2), (float*)(ws + WS_SSQ), (float*)(ws + WS_PART)};
        pg8::gemm_phase<pg8::EpiNorm, pg8::SchedTail>(lds, g, S, E);
    }
    SEAM(PH_WO);
    if (IN(PH_NORM1)) {
        const Args args = fetch_args<((GMASK >> PH_NORM1) & 1) != 0>(lds); unsigned char* ws = args.ws;
        p5_rows(args, gw, NGW, lane);
    }
    SEAM(PH_NORM1);
    if (IN(PH_UP)) {
        const Args args = fetch_args<((GMASK >> PH_UP) & 1) != 0>(lds); unsigned char* ws = args.ws;
        pg8::Gemm g{(const bf16_t*)(ws + WS_H2), (const bf16_t*)(ws + WS_WUP), DM, DM, DM}; pg8::SchedUp S{G, bx};
        pg8::EpiUpConv E{ws, args.out, args.in[27], args.in[28], args.in[5], lds};
        pg8::gemm_phase<pg8::EpiUpConv, pg8::SchedUp>(lds, g, S, E);
        if (G - 1 - bx < 64) {
            if (tid == 0) { unsigned* cnt = (unsigned*)(ws + WS_CTL) + CW_UPDONE; unsigned* bw = (unsigned*)(ws + WS_CTL) + CW_BAR;
                for (int p = 0; p < 4; ++p) XB_SPIN(xb_ld(cnt + p * 32) < 44u, bw);
                __builtin_amdgcn_fence(__ATOMIC_ACQUIRE, "agent"); }
            __syncthreads();
            pg8::Gemm g2{(const bf16_t*)(ws + WS_HG), (const bf16_t*)(ws + WS_WDN), FF, FF, FF}; pg8::SchedPieces S2{G, bx};
            pg8::EpiNorm E2{(bf16_t*)(ws + WS_F), (float*)(ws + WS_SSQ2), (float*)(ws + WS_PART2)};
            pg8::gemm_phase<pg8::EpiNorm, pg8::SchedPieces>(lds, g2, S2, E2);
        }
    }
    SEAM(PH_UP);
    if (IN(PH_DOWN)) {
        const Args args = fetch_args<((GMASK >> PH_DOWN) & 1) != 0>(lds); unsigned char* ws = args.ws;
        pg8::SchedTail S{G, bx, 88, 0};
        { pg8::Unit u; for (int i = 0; S.next(i, u); ++i) if (u.om < 64 && (u.om & 15) != 0) seam_rows(args, u.om); }
        asm volatile("s_waitcnt vmcnt(0)" ::: "memory"); __syncthreads();
        pg8::Gemm g{(const bf16_t*)(ws + WS_HG), (const bf16_t*)(ws + WS_WDN), FF, FF, FF};
        pg8::EpiNorm E{(bf16_t*)(ws + WS_F), (float*)(ws + WS_SSQ2), (float*)(ws + WS_PART2)};
        pg8::gemm_phase<pg8::EpiNorm, pg8::SchedTail>(lds, g, S, E);
    }
    SEAM(PH_DOWN);
    if (IN(PH_FINAL)) { const Args args = fetch_args<((GMASK >> PH_FINAL) & 1) != 0>(lds); p9_rows(args, gw, NGW, lane); }
#undef IN
#undef SEAM
}

#ifndef MK_PER_PHASE
#define MK_PER_PHASE 0
#endif
extern "C" void kernel_launch(void* const* d_in, const int* in_sizes, int n_in, void* d_out, int out_size, void* d_ws, size_t ws_size, hipStream_t stream) {
    static int grid = 0;
    if (grid == 0) {
        if (n_in != 31 || in_sizes[0] != NPROMPT * DM || out_size != (int)O_TOTAL || ws_size < WS_END) {
            fprintf(stderr, "kernel_launch: unexpected shapes: n_in %d in0 %d out %d ws %zu (need %zu)\n", n_in, n_in > 0 ? in_sizes[0] : -1, out_size, ws_size, (size_t)WS_END); grid = -1; return; }
        int dev = 0, cus = 0;
        if (hipGetDevice(&dev) != hipSuccess || hipDeviceGetAttribute(&cus, hipDeviceAttributeMultiprocessorCount, dev) != hipSuccess) { grid = -1; return; }
        if (hipFuncSetAttribute((const void*)fwd_kernel, hipFuncAttributeMaxDynamicSharedMemorySize, LDS_BYTES) != hipSuccess) { fprintf(stderr, "kernel_launch: hipFuncSetAttribute failed\n"); grid = -1; return; }
        int per_cu = 0;
        if (hipOccupancyMaxActiveBlocksPerMultiprocessor(&per_cu, (const void*)fwd_kernel, 512, LDS_BYTES) != hipSuccess || per_cu < 1) fprintf(stderr, "kernel_launch: occupancy query reports %d\n", per_cu);
        (void)hipGetLastError();
        grid = cus;
    }
    if (grid < 0) return;
    if (hipMemsetAsync((char*)d_ws + WS_CTL, 0, CTL_ZERO_BYTES, stream) != hipSuccess) return;
    Args a{};
    for (int i = 0; i < 31; ++i) a.in[i] = (const float*)d_in[i];
    a.out = (float*)d_out; a.ws = (unsigned char*)d_ws;
#if MK_PER_PHASE
    for (int p = 0; p < NPH; ++p) { a.ph_lo = p; a.ph_hi = p + 1; a.li = 0; hipLaunchKernelGGL(fwd_kernel, dim3(grid), dim3(512), LDS_BYTES, stream, a); }
#else
    a.ph_lo = 0; a.ph_hi = NPH; a.li = 0;
    hipLaunchKernelGGL(fwd_kernel, dim3(grid), dim3(512), LDS_BYTES, stream, a);
#endif
}
```

```cpp
#include <hip/hip_runtime.h>
#include <cstdio>
#include <cstddef>

#define LAS __attribute__((address_space(3)))
#define GAS __attribute__((address_space(1)))
typedef unsigned short bf16_t;
typedef short bf16x8 __attribute__((ext_vector_type(8)));
typedef short s16x4 __attribute__((ext_vector_type(4)));
typedef float f32x4 __attribute__((ext_vector_type(4)));
typedef float f32x2 __attribute__((ext_vector_type(2)));
typedef float f32x16 __attribute__((ext_vector_type(16)));
typedef unsigned u32x4 __attribute__((ext_vector_type(4)));
typedef unsigned u32x2 __attribute__((ext_vector_type(2)));
typedef __bf16 bf16x2_t __attribute__((ext_vector_type(2)));
typedef GAS unsigned gu32;
#define RLX_AGENT __ATOMIC_RELAXED, __HIP_MEMORY_SCOPE_AGENT
#define DI __device__ __forceinline__

DI unsigned pk_bf16(float lo, float hi) { f32x2 v = {lo, hi}; bf16x2_t b = __builtin_convertvector(v, bf16x2_t); return __builtin_bit_cast(unsigned, b); }
DI float bf_lo(unsigned w) { return __uint_as_float(w << 16); }
DI float bf_hi(unsigned w) { return __uint_as_float(w & 0xffff0000u); }
DI float bf2f(bf16_t b) { return __uint_as_float(((unsigned)b) << 16); }
DI u32x4 pack8(f32x4 a, f32x4 b) { u32x4 w; w.x = pk_bf16(a[0], a[1]); w.y = pk_bf16(a[2], a[3]); w.z = pk_bf16(b[0], b[1]); w.w = pk_bf16(b[2], b[3]); return w; }
DI float fsigmoid(float x) { return __builtin_amdgcn_rcpf(1.0f + __expf(-x)); }

constexpr int DM = 2048, NPROMPT = 4 * 4096, NSAMPLE = 32 * 32, MTOK = NPROMPT + NSAMPLE;
constexpr int NMEMROWS = 4 * 256;
constexpr int INW = 4112, FF = 5632, F2 = 11264, FH = 2816;
constexpr float EPS = 1e-6f;
constexpr float MQ_SCALE = 0.08838834764831845f * 1.4426950408889634f;

constexpr int PN_XN = 0, PN_MN = 68, PN_W = 72;
constexpr int WP_U = 0, WP_Q = 2, WP_K = 4, WP_MQ = 6, WP_ALR = 8, WP_G = 9, WP_V = 33, WP_R = 37, WP_MK = 41, WP_MV = 43, WP_END = 45;
constexpr int RB_ROWS = (PN_W + WP_END) * 256;

constexpr size_t MiB = 1u << 20;
constexpr size_t WS_CTL = 0, CTL_ZERO_BYTES = 32768;
constexpr size_t WS_RB = 1 * MiB;
constexpr size_t WS_WUP = 1 * MiB;
constexpr size_t WS_BR = 45 * MiB;
constexpr size_t WS_WDN = 203 * MiB;
constexpr size_t WS_H2 = 67 * MiB;
constexpr size_t WS_WB = 118 * MiB;
constexpr size_t WS_U = 126 * MiB;
constexpr size_t WS_Q = 160 * MiB, WS_K = 177 * MiB, WS_MQ = 194 * MiB;
constexpr size_t WS_ALR = 211 * MiB;
constexpr size_t WS_KM = 213 * MiB, WS_VMT = 214 * MiB, WS_KS = 215 * MiB, WS_VST = 223 * MiB;
constexpr size_t WS_VRT = 231 * MiB;
constexpr size_t WS_G = 299 * MiB;
constexpr size_t WS_WO = 503 * MiB;
constexpr size_t WS_MG = 135 * MiB;
constexpr size_t WS_Y2 = 231 * MiB;
constexpr size_t WS_SSQ = 225 * MiB;
constexpr size_t WS_SCR = 135 * MiB;
constexpr size_t WS_HEAD = 231 * MiB, WS_TAIL = 238 * MiB;
constexpr size_t WS_HG = 322 * MiB;
constexpr size_t WS_F = 135 * MiB;
constexpr size_t WS_SSQ2 = 228 * MiB;
constexpr size_t WS_AGG = 126 * MiB, WS_DCUM = 141 * MiB;
constexpr size_t WS_PART = 299 * MiB;
constexpr size_t WS_PART2 = 246 * MiB;
constexpr size_t WS_END = 512 * MiB;
static_assert(WS_RB + (size_t)RB_ROWS * DM * 2 <= WS_WB, "RB");
static_assert(WS_HG + (size_t)MTOK * FF * 2 <= 511 * MiB, "HG");
static_assert(WS_G + (size_t)MTOK * 6144 * 2 <= WS_WO, "G");
static_assert(WS_VRT + (size_t)2048 * MTOK * 2 <= WS_G, "VRT");

constexpr size_t O_Y = 0, O_POOLP = 35651584, O_POOLS = 35682304, O_GLAP = 35928064, O_GLAS = 36452352, O_CONVP = 40646656, O_CONVS = 40736768, O_MEMK = 41457664, O_MEMV = 41981952, O_TOTAL = 42506240;

constexpr int CW_BAR = 4096;
constexpr int CW_UPDONE = 64;

constexpr int RING_BYTES = 131072, LDSCTL_OFF = RING_BYTES, MISC_OFF = LDSCTL_OFF + 320, LDS_BYTES = 131072 + 1024 + 16384 + 2048;

namespace pg8 {
constexpr int BM = 256, BK = 64, HALF = 128, HTB = HALF * BK * 2, STAGE_BYTES = 8 * HTB;
DI int lds_byte(int r, int c) { const int st = (r >> 4) * 2 + (c >> 5), rr = r & 15, cc = c & 31, ob = rr * 64 + cc * 2; return st * 1024 + (ob ^ (((ob >> 9) & 1) << 5)); }
DI void stage_rc(int b, int& R, int& C) { const int st = b / 1024, sb = b % 1024, swz = sb ^ (((sb >> 9) & 1) << 5); R = (st >> 1) * 16 + swz / 64; C = (st & 1) * 32 + (swz % 64) / 2; }
DI int perm32(int rho) { const int n = rho >> 4, i = rho & 15; return 8 * (i >> 2) + 4 * n + (i & 3); }

struct Unit { int arow, brow, kind, om, on, koff, nt, seq; };
struct Gemm { const bf16_t* A; const bf16_t* B; int lda, ldb, K; };

#ifndef P1_CHIPWIDE
#define P1_CHIPWIDE 1
#endif
#ifndef GEMM_WGM
#define GEMM_WGM 4
#endif
DI void grid_map(int wgid, int nM, int nN, int& pm, int& pn, int wgm = 8) {
    const int nwg = nM * nN; { const int q = nwg / 8, r = nwg % 8, xcd = wgid % 8, off = wgid / 8; wgid = (xcd < r ? xcd * (q + 1) : r * (q + 1) + (xcd - r) * q) + off; }
    const int nig = wgm * nN, gid = wgid / nig, fm = gid * wgm, gsz = (nM - fm) < wgm ? (nM - fm) : wgm;
    pm = fm + ((wgid % nig) % gsz); pn = (wgid % nig) / gsz;
    if (nN == 8 && gsz == 8) { pm = fm + (wgid % nig) / 8; pn = (wgid % nig) % 8; }
}
struct Sched2D {
    int nM, nN, G, c, a0, b0, ntK;
    DI bool next(int i, Unit& u) const { const long L = (long)i * G + c; if (L >= (long)nM * nN) return false; int pm, pn; grid_map((int)L, nM, nN, pm, pn);
        u.arow = (a0 + pm) * 256; u.brow = (b0 + pn) * 256; u.kind = 0; u.om = pm; u.on = pn; u.koff = 0; u.nt = ntK; return true; }
};
struct SchedTail {
    int G, c, ntK, np;
    DI bool next(int i, Unit& u) const { const long L = (long)i * G + c; if (L >= 512 + np) return false;
        int pm = 0, pn = 0; grid_map(L < 512 ? (int)L : 0, 64, 8, pm, pn);
        const int x = (int)L - 512, t = x >> 2, kq = x & 3; const bool full = L < 512;
        const int om = full ? pm : 64 + (t >> 3), on = full ? pn : (t & 7);
        Unit r; r.seq = 0; r.arow = om * 256; r.brow = on * 256; r.kind = full ? 0 : 1 + kq; r.om = om; r.on = on; r.koff = full ? 0 : kq * (ntK / 4) * 64; r.nt = full ? ntK : ntK / 4;
        u = r; return true; }
};
struct SchedOne { int pm, pn, ntK;
    DI bool next(int i, Unit& u) const { if (i > 0) return false; Unit r; r.arow = pm * 256; r.brow = pn * 256; r.kind = 0; r.om = pm; r.on = pn; r.koff = 0; r.nt = ntK; r.seq = 0; u = r; return true; } };
struct SchedUp { int G, c;
    DI bool next(int i, Unit& u) const { const long L = (long)i * G + c; if (L >= 68 * 44) return false; int pm, pn;
        if (L < 176) { const int x = (int)L & 7, t = (int)L >> 3; pm = 64 + (x & 3); pn = 2 * t + (x >> 2); }
        else grid_map((int)L - 176, 64, 44, pm, pn, GEMM_WGM);
        Unit r; r.arow = pm * 256; r.brow = pn * 256; r.kind = 0; r.om = pm; r.on = pn; r.koff = 0; r.nt = 32; r.seq = 0; u = r; return true; } };
struct SchedPieces { int G, c;
    DI bool next(int i, Unit& u) const { const int j = (G - 1 - c) + i * G; if (j >= 64) return false; const int t = j >> 1, kq = j & 1;
        Unit r; r.om = 64 + (t >> 3); r.on = t & 7; r.arow = r.om * 256; r.brow = r.on * 256; r.kind = 1 + kq; r.koff = kq * 44 * 64; r.nt = 44; r.seq = 0; u = r; return true; } };
struct SchedP1 {
    int G, c;
    static constexpr int N0 = 68 * 33, N1 = 8 * 68, N2 = 24;
    DI bool next(int i, Unit& u) const { long L = (long)i * G + c; if (L >= N0 + N1 + N2) return false; int pm, pn; u.koff = 0; u.nt = 32;
        if (L < N0) {
            if (P1_CHIPWIDE) { const int l = (int)L;
                if (l < 68 * 32) { const int x = l & 7, k = (l >> 3) & 31, sg = l >> 8; if (sg < 8) { pm = 8 * sg + (k & 7); pn = 4 * x + (k >> 3); } else { pm = 64 + (k & 3); pn = 4 * x + (k >> 2); } }
                else { pm = l - 68 * 32; pn = 32; } }
            else grid_map((int)L, 68, 33, pm, pn, GEMM_WGM); u.arow = (PN_XN + pm) * 256; u.brow = (PN_W + pn) * 256; u.kind = 0; u.om = pm; u.on = pn; return true; }
        L -= N0;
        if (L < N1) { grid_map((int)L, 8, 68, pm, pn); u.arow = (PN_W + WP_V + pm) * 256; u.brow = (PN_XN + pn) * 256; u.kind = 1; u.om = pm; u.on = pn; return true; }
        L -= N1; const int j = (int)L & 7, t = (int)L >> 3;
        if (t == 0) { u.om = j >> 1; u.on = j & 1; u.arow = (PN_MN + u.om) * 256; u.brow = (PN_W + WP_MK + u.on) * 256; u.kind = 2; }
        else if (t == 1) { u.om = j >> 1; u.on = j & 1; u.arow = (PN_MN + u.om) * 256; u.brow = (PN_W + WP_MV + u.on) * 256; u.kind = 3; }
        else { u.om = j >> 2; u.on = j & 3; u.arow = (PN_W + WP_MV + u.om) * 256; u.brow = (PN_MN + u.on) * 256; u.kind = 4; }
        return true; }
};

DI u32x4 quad16(u32x4 w, int lane) { const int src = (((lane >> 2) + 16 * (lane & 3)) << 2); u32x4 r;
    r.x = (unsigned)__builtin_amdgcn_ds_bpermute(src, (int)w.x); r.y = (unsigned)__builtin_amdgcn_ds_bpermute(src, (int)w.y); r.z = (unsigned)__builtin_amdgcn_ds_bpermute(src, (int)w.z); r.w = (unsigned)__builtin_amdgcn_ds_bpermute(src, (int)w.w); return r; }
typedef f32x4 Acc[2][2][4][2];

struct EpiP1 {
    static constexpr bool HOOK = false;
    unsigned char* ws; float* out; const float* bgate;
    DI void mid(Acc&, const Unit&, int, int, int, int, int) const {}
    DI void operator()(Acc& acc, const Unit& u, int wr, int wc, int fr, int fq) const {
        const int rl = wr * 64 + fr, cl = wc * 32 + 8 * fq;
        float* pf = nullptr; bf16_t* pb = nullptr; unsigned ld = 0; int act = 0; float scale = 1.f; const float* bias = nullptr; bool ok0 = true, ok1 = true;
        const int k = u.kind;
        if (k == 0) {
            const int wp = u.on; const size_t r0 = (size_t)u.om * 256;
            if (wp < WP_Q) { pf = (float*)(ws + WS_U) + r0 * 512 + wp * 256; ld = 512; }
            else if (wp < WP_K) { pb = (bf16_t*)(ws + WS_Q) + r0 * 512 + (wp - WP_Q) * 256; ld = 512; }
            else if (wp < WP_MQ) { pb = (bf16_t*)(ws + WS_K) + r0 * 512 + (wp - WP_K) * 256; ld = 512; }
            else if (wp < WP_ALR) { pb = (bf16_t*)(ws + WS_MQ) + r0 * 512 + (wp - WP_MQ) * 256; ld = 512; scale = MQ_SCALE; }
            else if (wp == WP_ALR) { pf = (float*)(ws + WS_ALR) + r0 * 16; ld = 16; ok0 = (cl < 16); ok1 = false; }
            else { pb = (bf16_t*)(ws + WS_G + (size_t)(u.om * 24 + (wp - WP_G)) * 65536); ld = 256; act = 2; bias = bgate + (wp - WP_G) * 256; }
        } else if (k == 1) { pb = (bf16_t*)(ws + WS_VRT) + (size_t)u.om * 256 * MTOK + u.on * 256; ld = MTOK; act = (u.om >= 4) ? 3 : 0; }
        else if (k == 2) { pf = out + O_MEMK + (size_t)u.om * 256 * 512 + u.on * 256; pb = (bf16_t*)(ws + WS_KM) + (size_t)u.om * 256 * 512 + u.on * 256; ld = 512; }
        else if (k == 3) { pf = out + O_MEMV + (size_t)u.om * 256 * 512 + u.on * 256; ld = 512; }
        else { pb = (bf16_t*)(ws + WS_VMT) + (size_t)u.om * 256 * 1024 + u.on * 256; ld = 1024; }
        const unsigned lo32 = (unsigned)rl * ld + (unsigned)cl;
        const int lane = fr + 16 * fq; const unsigned lq32 = (unsigned)(wr * 64 + (lane >> 2)) * ld + (unsigned)(wc * 32 + 8 * (lane & 3));
#pragma unroll
        for (int bj = 0; bj < 2; ++bj) {
            if (bj == 0 ? !ok0 : !ok1) continue;
            f32x4 b0 = {0.f, 0.f, 0.f, 0.f}, b1 = b0;
            if (act == 2) { b0 = *(const f32x4*)(bias + cl + bj * HALF); b1 = *(const f32x4*)(bias + cl + bj * HALF + 4); }
#pragma unroll
            for (int ai = 0; ai < 2; ++ai)
#pragma unroll
                for (int m = 0; m < 4; ++m) {
                    const size_t uo = (size_t)((ai * HALF + m * 16) * ld + bj * HALF);
                    f32x4 v0 = acc[ai][bj][m][0], v1 = acc[ai][bj][m][1];
                    if (act == 2) {
                        unsigned q[8];
#pragma unroll
                        for (int e = 0; e < 4; ++e) {
                            q[e] = (unsigned)fmaxf(__builtin_amdgcn_rcpf(1.0f + __builtin_amdgcn_exp2f((v0[e] + b0[e]) * -1.4426950408889634f)) * 255.0f + 0.5f, 1.0f);
                            q[4 + e] = (unsigned)fmaxf(__builtin_amdgcn_rcpf(1.0f + __builtin_amdgcn_exp2f((v1[e] + b1[e]) * -1.4426950408889634f)) * 255.0f + 0.5f, 1.0f); }
                        u32x2 w; w.x = q[0] | (q[1] << 8) | (q[2] << 16) | (q[3] << 24); w.y = q[4] | (q[5] << 8) | (q[6] << 16) | (q[7] << 24);
                        *(u32x2*)((unsigned char*)pb + (size_t)(((ai * 4 + m) * 2 + bj) * 8 + wr * 4 + wc) * 512 + lane * 8) = w;
                        continue;
                    } else if (act == 3) {
#pragma unroll
                        for (int e = 0; e < 4; ++e) { v0[e] = v0[e] * fsigmoid(v0[e]); v1[e] = v1[e] * fsigmoid(v1[e]); }
                    } else { v0 = v0 * scale; v1 = v1 * scale; }
                    if (pf) { float* p = pf + uo; *(f32x4*)(p + lo32) = v0; *(f32x4*)(p + lo32 + 4) = v1; }
                    if (pb) { bf16_t* p = pb + uo; *(u32x4*)(p + lq32) = quad16(pack8(v0, v1), lane); }
                }
        }
    }
};

DI float ub8(unsigned w, int k) { return (float)((w >> (8 * k)) & 0xffu); }
struct EpiMerge {
    static constexpr bool HOOK = true;
    unsigned char* ws;
    DI void mid(Acc& acc, const Unit& u, int t, int wr, int wc, int fr, int fq) const {
        if (t != 8 && t != 24) return;
        const unsigned lo8 = (unsigned)(((wr * 4 + wc) * 64 + fr + 16 * fq) * 8);
        const unsigned char* gp = ws + WS_G + (size_t)(u.om * 24 + (t == 8 ? 0 : 8) + u.on) * 65536;
        u32x2 ga[2][4][2], gb[2][4][2];
#pragma unroll
        for (int ai = 0; ai < 2; ++ai)
#pragma unroll
            for (int m = 0; m < 4; ++m)
#pragma unroll
                for (int bj = 0; bj < 2; ++bj) { const unsigned char* p = gp + (size_t)(((ai * 4 + m) * 2 + bj) * 4096); ga[ai][m][bj] = *(const u32x2*)(p + lo8); gb[ai][m][bj] = *(const u32x2*)(p + 8 * 65536 + lo8); }
#pragma unroll
        for (int ai = 0; ai < 2; ++ai)
#pragma unroll
            for (int m = 0; m < 4; ++m)
#pragma unroll
                for (int bj = 0; bj < 2; ++bj) { const u32x2 a = ga[ai][m][bj], b = gb[ai][m][bj];
                    f32x4 r0, r1;
#pragma unroll
                    for (int e = 0; e < 4; ++e) { r0[e] = ub8(a.x, e) * __builtin_amdgcn_rcpf(ub8(b.x, e)); r1[e] = ub8(a.y, e) * __builtin_amdgcn_rcpf(ub8(b.y, e)); }
                    acc[ai][bj][m][0] *= r0; acc[ai][bj][m][1] *= r1; }
        asm volatile("" ::: "memory");
    }
    DI void operator()(Acc& acc, const Unit& u, int wr, int wc, int fr, int fq) const {
        const int lane = fr + 16 * fq;
        const unsigned lg8 = (unsigned)(((wr * 4 + wc) * 64 + lane) * 8), lo32 = (unsigned)(wr * 64 + (lane >> 2)) * (unsigned)DM + (unsigned)(wc * 32 + 8 * (lane & 3));
        const unsigned char* gp = ws + WS_G + (size_t)(u.om * 24 + 16 + u.on) * 65536;
        bf16_t* op = (bf16_t*)(ws + WS_MG) + (size_t)u.om * 256 * DM + u.on * 256;
#pragma unroll
        for (int ai = 0; ai < 2; ++ai) {
            u32x2 ga[4][2];
#pragma unroll
            for (int m = 0; m < 4; ++m)
#pragma unroll
                for (int bj = 0; bj < 2; ++bj) ga[m][bj] = *(const u32x2*)(gp + (size_t)(((ai * 4 + m) * 2 + bj) * 4096) + lg8);
#pragma unroll
            for (int m = 0; m < 4; ++m)
#pragma unroll
                for (int bj = 0; bj < 2; ++bj) { const u32x2 a = ga[m][bj];
                    f32x4 v0 = acc[ai][bj][m][0], v1 = acc[ai][bj][m][1];
#pragma unroll
                    for (int e = 0; e < 4; ++e) { v0[e] *= ub8(a.x, e) * (1.0f / 255.0f); v1[e] *= ub8(a.y, e) * (1.0f / 255.0f); }
                    *(u32x4*)(op + (size_t)((ai * HALF + m * 16) * DM + bj * HALF) + lo32) = quad16(pack8(v0, v1), lane); }
            asm volatile("" ::: "memory");
        }
    }
};

struct EpiNorm {
    static constexpr bool HOOK = false;
    bf16_t* Y; float* SSQ; float* PART;
    DI void mid(Acc&, const Unit&, int, int, int, int, int) const {}
    DI void operator()(Acc& acc, const Unit& u, int wr, int wc, int fr, int fq) const {
        if (u.kind != 0) {
            float* pp = PART + ((size_t)(u.kind - 1) * 1024 + (size_t)(u.om - 64) * 256) * DM + u.on * 256;
            const unsigned lp32 = (unsigned)(wr * 64 + fr) * (unsigned)DM + (unsigned)(wc * 32 + 8 * fq);
#pragma unroll
            for (int ai = 0; ai < 2; ++ai)
#pragma unroll
                for (int m = 0; m < 4; ++m)
#pragma unroll
                    for (int bj = 0; bj < 2; ++bj) { float* p = pp + (size_t)((ai * HALF + m * 16) * DM + bj * HALF); *(f32x4*)(p + lp32) = acc[ai][bj][m][0]; *(f32x4*)(p + lp32 + 4) = acc[ai][bj][m][1]; }
            return;
        }
        const int lane = fr + 16 * fq;
        const unsigned lo32 = (unsigned)(wr * 64 + (lane >> 2)) * (unsigned)DM + (unsigned)(wc * 32 + 8 * (lane & 3)), ls32 = (unsigned)(wr * 64 + fr) * 32u;
        bf16_t* op = Y + (size_t)u.om * 256 * DM + u.on * 256; float* sp = SSQ + (size_t)u.om * 256 * 32 + u.on * 4 + wc;
#pragma unroll
        for (int ai = 0; ai < 2; ++ai)
#pragma unroll
            for (int m = 0; m < 4; ++m) {
                float s = 0.f;
#pragma unroll
                for (int bj = 0; bj < 2; ++bj) {
                    const f32x4 v0 = acc[ai][bj][m][0], v1 = acc[ai][bj][m][1];
                    s += (v0[0] * v0[0] + v0[1] * v0[1]) + (v0[2] * v0[2] + v0[3] * v0[3]) + (v1[0] * v1[0] + v1[1] * v1[1]) + (v1[2] * v1[2] + v1[3] * v1[3]);
                    *(u32x4*)(op + (size_t)((ai * HALF + m * 16) * DM + bj * HALF) + lo32) = quad16(pack8(v0, v1), lane);
                }
                s += __shfl_xor(s, 16); s += __shfl_xor(s, 32);
                if (fq == 0) sp[(size_t)((ai * HALF + m * 16) * 32) + ls32] = s;
            }
    }
};

DI float gelu_tanh_f(float x) { const float z = 1.5957691216057308f * (x + 0.044715f * x * x * x); return x * __builtin_amdgcn_rcpf(1.0f + __expf(-z)); }
DI void unpack8(u32x4 w, float (&v)[8]) { v[0] = bf_lo(w.x); v[1] = bf_hi(w.x); v[2] = bf_lo(w.y); v[3] = bf_hi(w.y); v[4] = bf_lo(w.z); v[5] = bf_hi(w.z); v[6] = bf_lo(w.w); v[7] = bf_hi(w.w); }
DI void unpack4(u32x2 w, float (&v)[4]) { v[0] = bf_lo(w.x); v[1] = bf_hi(w.x); v[2] = bf_lo(w.y); v[3] = bf_hi(w.y); }
constexpr int UPC_A = 3 * 16384, UPC_B = 131072 + 1024, UPC_CARRY = UPC_B + 16384;
struct EpiUpConv {
    static constexpr bool HOOK = false;
    unsigned char* ws; float* out; const float* wdw; const float* bdw; const float* hist; LAS unsigned char* lds;
    DI void mid(Acc&, const Unit&, int, int, int, int, int) const {}
    DI void operator()(Acc& acc, const Unit& u, int wr, int wc, int fr, int fq) const {
        const bool sample = u.om >= 64, contin = !sample && (u.om & 15) != 0;
        int tid = threadIdx.x; asm volatile("" : "+v"(tid));
        fr = tid & 15; fq = (tid >> 4) & 3;
        const int fgp = tid & 31, rg = tid >> 5, feat = u.on * 128 + fgp * 4;
        f32x4 wg[3], wv[3], bg, bv;
#pragma unroll
        for (int i = 0; i < 3; ++i) { wg[i] = *(const f32x4*)(wdw + (size_t)i * F2 + feat); wv[i] = *(const f32x4*)(wdw + (size_t)i * F2 + FF + feat); }
        bg = *(const f32x4*)(bdw + feat); bv = *(const f32x4*)(bdw + FF + feat);
        u32x4 pk[2][4][2];
        {
            const int rl = wr * 64 + fr, cl = wc * 32 + 8 * fq;
#pragma unroll
            for (int ai = 0; ai < 2; ++ai)
#pragma unroll
                for (int m = 0; m < 4; ++m) {
                    const int row = rl + ai * HALF + m * 16, gm = u.om * 256 + row; float* cp = nullptr;
                    if (!sample) { const int t = gm & 4095; if (t >= 4094) cp = out + O_CONVP + ((size_t)(gm >> 12) * 2 + (t - 4094)) * F2; }
                    else { const int t = (gm - NPROMPT) & 31; if (t >= 30) cp = out + O_CONVS + ((size_t)((gm - NPROMPT) >> 5) * 2 + (t - 30)) * F2; }
                    if (cp) {
#pragma unroll
                        for (int bj = 0; bj < 2; ++bj) { float* q = cp + bj * FF + u.on * 128 + cl; *(f32x4*)q = acc[ai][bj][m][0]; *(f32x4*)(q + 4) = acc[ai][bj][m][1]; } }
#pragma unroll
                    for (int bj = 0; bj < 2; ++bj) pk[ai][m][bj] = pack8(acc[ai][bj][m][0], acc[ai][bj][m][1]);
                }
        }
        LAS unsigned char* chA = lds + UPC_A; LAS unsigned char* chB = lds + UPC_B; LAS unsigned char* carry = lds + UPC_CARRY;
#pragma unroll
        for (int c = 0; c < 4; ++c) {
            if (wr == (c & 1)) {
#pragma unroll
                for (int m = 0; m < 4; ++m)
#pragma unroll
                    for (int bj = 0; bj < 2; ++bj) { const int row = m * 16 + fr, gran = bj * 16 + wc * 4 + fq;
                        *(LAS u32x4*)(((row & 32) ? chB : chA) + (row & 31) * 512 + ((gran ^ (row & 31)) << 4)) = pk[c >> 1][m][bj]; }
            }
            asm volatile("s_waitcnt lgkmcnt(0)" ::: "memory"); __builtin_amdgcn_s_barrier(); asm volatile("" ::: "memory");
            u32x2 gr[6], vr[6];
#pragma unroll
            for (int i = 0; i < 6; ++i) {
                const int r = 4 * rg - 2 + i;
                if (i >= 2 || rg > 0) { const LAS unsigned char* p = ((r & 32) ? chB : chA) + (r & 31) * 512; const int sw = r & 31;
                    gr[i] = *(const LAS u32x2*)(p + (((fgp >> 1) ^ sw) << 4) + (fgp & 1) * 8); vr[i] = *(const LAS u32x2*)(p + (((16 + (fgp >> 1)) ^ sw) << 4) + (fgp & 1) * 8); }
                else if (c > 0) { const LAS unsigned char* q = carry + ((c - 1) & 1) * 1024 + i * 512; gr[i] = *(const LAS u32x2*)(q + fgp * 8); vr[i] = *(const LAS u32x2*)(q + 256 + fgp * 8); }
                else { gr[i] = (u32x2){0u, 0u}; vr[i] = gr[i]; }
            }
            f32x2 G[6][2], V[6][2];
#pragma unroll
            for (int i = 0; i < 6; ++i) { float t4[4]; unpack4(gr[i], t4); G[i][0] = (f32x2){t4[0], t4[1]}; G[i][1] = (f32x2){t4[2], t4[3]}; unpack4(vr[i], t4); V[i][0] = (f32x2){t4[0], t4[1]}; V[i][1] = (f32x2){t4[2], t4[3]}; }
            if (sample && (rg & 7) == 0) {
                const int b = ((u.om - 64) * 256 + c * 64 + 4 * rg) >> 5; const float* hp = hist + (size_t)b * 2 * F2 + feat;
                const f32x4 a0 = *(const f32x4*)hp, a1 = *(const f32x4*)(hp + F2), c0 = *(const f32x4*)(hp + FF), c1 = *(const f32x4*)(hp + F2 + FF);
                G[0][0] = (f32x2){a0[0], a0[1]}; G[0][1] = (f32x2){a0[2], a0[3]}; G[1][0] = (f32x2){a1[0], a1[1]}; G[1][1] = (f32x2){a1[2], a1[3]};
                V[0][0] = (f32x2){c0[0], c0[1]}; V[0][1] = (f32x2){c0[2], c0[3]}; V[1][0] = (f32x2){c1[0], c1[1]}; V[1][1] = (f32x2){c1[2], c1[3]};
            }
            if (!sample && ((c == 0 && rg == 0) || (c == 3 && rg == 15))) {
                float* hp = (float*)(ws + (c == 0 ? WS_HEAD : WS_TAIL)) + (size_t)u.om * 2 * F2 + feat;
#pragma unroll
                for (int rr = 0; rr < 2; ++rr) { const int ri = (c == 0 ? 2 : 4) + rr;
                    *(f32x4*)(hp + (size_t)rr * F2) = (f32x4){G[ri][0].x, G[ri][0].y, G[ri][1].x, G[ri][1].y}; *(f32x4*)(hp + (size_t)rr * F2 + FF) = (f32x4){V[ri][0].x, V[ri][0].y, V[ri][1].x, V[ri][1].y}; }
            }
            bf16_t* op = (bf16_t*)(ws + WS_HG) + ((size_t)u.om * 256 + c * 64 + 4 * rg) * FF + feat;
            const f32x2 K1 = {-2.3022082f, -2.3022082f}, K3 = {-0.10294324f, -0.10294324f}, ONE = {1.0f, 1.0f};
            f32x2 CG[4][2], CV[4][2], UU[4][2];
#pragma unroll
            for (int p = 0; p < 2; ++p) {
                const f32x2 w0 = {wg[0][2 * p], wg[0][2 * p + 1]}, w1 = {wg[1][2 * p], wg[1][2 * p + 1]}, w2 = {wg[2][2 * p], wg[2][2 * p + 1]}, wb = {bg[2 * p], bg[2 * p + 1]};
                const f32x2 x0 = {wv[0][2 * p], wv[0][2 * p + 1]}, x1 = {wv[1][2 * p], wv[1][2 * p + 1]}, x2 = {wv[2][2 * p], wv[2][2 * p + 1]}, xb = {bv[2 * p], bv[2 * p + 1]};
#pragma unroll
                for (int i = 0; i < 4; ++i) { CG[i][p] = w0 * G[i][p] + (w1 * G[i + 1][p] + (w2 * G[i + 2][p] + wb)); CV[i][p] = x0 * V[i][p] + (x1 * V[i + 1][p] + (x2 * V[i + 2][p] + xb)); }
            }
#pragma unroll
            for (int i = 0; i < 4; ++i)
#pragma unroll
                for (int p = 0; p < 2; ++p) UU[i][p] = CG[i][p] * (CG[i][p] * CG[i][p] * K3 + K1);
#pragma unroll
            for (int i = 0; i < 4; ++i)
#pragma unroll
                for (int p = 0; p < 2; ++p) UU[i][p] = (f32x2){__builtin_amdgcn_exp2f(UU[i][p].x), __builtin_amdgcn_exp2f(UU[i][p].y)} + ONE;
#pragma unroll
            for (int i = 0; i < 4; ++i)
#pragma unroll
                for (int p = 0; p < 2; ++p) UU[i][p] = (f32x2){__builtin_amdgcn_rcpf(UU[i][p].x), __builtin_amdgcn_rcpf(UU[i][p].y)};
#pragma unroll
            for (int i = 0; i < 4; ++i) {
                const f32x2 h0 = CG[i][0] * UU[i][0] * CV[i][0], h1 = CG[i][1] * UU[i][1] * CV[i][1];
                if (!(contin && c == 0 && rg == 0 && i < 2)) { u32x2 w; w.x = pk_bf16(h0.x, h0.y); w.y = pk_bf16(h1.x, h1.y); *(u32x2*)(op + (size_t)i * FF) = w; }
            }
            if (c < 3 && rg == 15) { LAS unsigned char* q = carry + (c & 1) * 1024 + fgp * 8;
                *(LAS u32x2*)q = gr[4]; *(LAS u32x2*)(q + 256) = vr[4]; *(LAS u32x2*)(q + 512) = gr[5]; *(LAS u32x2*)(q + 768) = vr[5]; }
            asm volatile("s_waitcnt lgkmcnt(0)" ::: "memory"); __builtin_amdgcn_s_barrier(); asm volatile("" ::: "memory");
        }
        if (sample) {
            asm volatile("s_waitcnt vmcnt(0)" ::: "memory"); __builtin_amdgcn_s_barrier(); asm volatile("" ::: "memory");
            if (threadIdx.x == 0) { __builtin_amdgcn_fence(__ATOMIC_RELEASE, "agent"); (void)__hip_atomic_fetch_add((unsigned*)(ws + WS_CTL) + CW_UPDONE + (u.om - 64) * 32, 1u, __ATOMIC_RELAXED, __HIP_MEMORY_SCOPE_AGENT); }
        }
    }
};

template <class Epi, class Sched>
DI void gemm_phase(LAS unsigned char* lds, const Gemm g, const Sched& S, const Epi& E) {
    const int tid = threadIdx.x, wid = __builtin_amdgcn_readfirstlane(tid >> 6), lane = tid & 63, wr = wid >> 2, wc = wid & 3, fr = lane & 15, fq = lane >> 4;
    unsigned voffA[2], voffB[2];
#pragma unroll
    for (int i = 0; i < 2; ++i) { int R, C; stage_rc(tid * 16 + i * 8192, R, C); const int Rb = (R & ~31) + perm32(R & 31);
        voffA[i] = (unsigned)(R * g.lda + C) * 2u; voffB[i] = (unsigned)(Rb * g.ldb + C) * 2u; }
    const size_t kstep = (size_t)(BK * 2);
    const size_t hstepA = (size_t)HALF * g.lda * 2, hstepB = (size_t)HALF * g.ldb * 2;
    const size_t rstepA = (size_t)g.lda * 2, rstepB = (size_t)g.ldb * 2;
    const unsigned ldsw = (unsigned)wid * 1024u;
    const int aoff = lds_byte(wr * 64 + fr, fq * 8), boff = lds_byte(wc * 32 + fr, fq * 8);
#define PG8_SA(b, h) (((b) * 2 + (h)) * HTB)
#define PG8_SB(b, h) ((4 + (b) * 2 + (h)) * HTB)
#define PG8_STAGE(bufoff, gbase, voff) do { _Pragma("unroll") for (int _i = 0; _i < 2; ++_i) \
        __builtin_amdgcn_global_load_lds((const unsigned*)((const char*)(gbase) + (voff)[_i]), (LAS unsigned*)(lds + (bufoff) + ldsw + _i * 8192), 16, 0, 0); } while (0)
#define PG8_LDA(dst, b, h) do { _Pragma("unroll") for (int m = 0; m < 4; ++m) _Pragma("unroll") for (int k = 0; k < 2; ++k) dst[m][k] = *(const LAS bf16x8*)(lds + PG8_SA(b, h) + aoff + m * 2048 + k * 1024); } while (0)
#define PG8_LDB(dst, b, h) do { _Pragma("unroll") for (int n = 0; n < 2; ++n) _Pragma("unroll") for (int k = 0; k < 2; ++k) dst[n][k] = *(const LAS bf16x8*)(lds + PG8_SB(b, h) + boff + n * 2048 + k * 1024); } while (0)
#define PG8_MMA(ai, bj, At, Bt) do { __builtin_amdgcn_s_setprio(1); _Pragma("unroll") for (int m = 0; m < 4; ++m) _Pragma("unroll") for (int n = 0; n < 2; ++n) _Pragma("unroll") for (int k = 0; k < 2; ++k) \
        acc[ai][bj][m][n] = __builtin_amdgcn_mfma_f32_16x16x32_bf16(Bt[n][k], At[m][k], acc[ai][bj][m][n], 0, 0, 0); __builtin_amdgcn_s_setprio(0); } while (0)
#define PG8_WAIT_V(n) asm volatile("s_waitcnt vmcnt(" #n ")" ::: "memory")
#define PG8_WAIT_L(n) asm volatile("s_waitcnt lgkmcnt(" #n ")" ::: "memory")
#define PG8_BAR __builtin_amdgcn_s_barrier()
#define PG8_SCHED __builtin_amdgcn_sched_barrier(0)
    Unit cur, nxt; int ui = 0;
    if (!S.next(0, cur)) return;
    Acc acc;
#pragma unroll
    for (int a = 0; a < 2; ++a)
#pragma unroll
        for (int b = 0; b < 2; ++b)
#pragma unroll
            for (int m = 0; m < 4; ++m)
#pragma unroll
                for (int n = 0; n < 2; ++n) acc[a][b][m][n] = (f32x4){0.f, 0.f, 0.f, 0.f};
    bf16x8 At[4][2], B0[2][2], B1[2][2];
    const char* cA = (const char*)g.A + (size_t)cur.arow * rstepA + (size_t)cur.koff * 2; const char* cB = (const char*)g.B + (size_t)cur.brow * rstepB + (size_t)cur.koff * 2;
    PG8_STAGE(PG8_SB(0, 0), cB, voffB); PG8_STAGE(PG8_SB(0, 1), cB + hstepB, voffB); PG8_STAGE(PG8_SA(0, 0), cA, voffA); PG8_STAGE(PG8_SA(0, 1), cA + hstepA, voffA);
    if (wr == 1) PG8_BAR;
    PG8_WAIT_V(2); PG8_BAR;
    PG8_STAGE(PG8_SB(1, 0), cB + kstep, voffB); PG8_STAGE(PG8_SA(1, 0), cA + kstep, voffA); PG8_STAGE(PG8_SB(1, 1), cB + hstepB + kstep, voffB);
    PG8_WAIT_V(6); PG8_BAR;
    for (;;) {
        const bool has_next = S.next(ui + 1, nxt);
        const char* nA = has_next ? (const char*)g.A + (size_t)nxt.arow * rstepA + (size_t)nxt.koff * 2 : cA; const char* nB = has_next ? (const char*)g.B + (size_t)nxt.brow * rstepB + (size_t)nxt.koff * 2 : cB;
        const int nt = cur.nt;
        for (int t = 0; t < nt; t += 2) {
            const bool last = (t == nt - 2);
            const char* a1 = cA + (size_t)(t + 1) * kstep;
            const char* a2 = last ? nA : cA + (size_t)(t + 2) * kstep; const char* b2 = last ? nB : cB + (size_t)(t + 2) * kstep;
            const char* a3 = a2 + kstep; const char* b3 = b2 + kstep;
            if constexpr (Epi::HOOK) E.mid(acc, cur, t, wr, wc, fr, fq);
            PG8_LDB(B0, 0, 0); PG8_LDB(B1, 0, 1); PG8_SCHED; PG8_LDA(At, 0, 0); PG8_STAGE(PG8_SA(1, 1), a1 + hstepA, voffA);
            PG8_WAIT_V(8); PG8_WAIT_L(0); PG8_BAR; PG8_MMA(0, 0, At, B0); PG8_MMA(0, 1, At, B1); PG8_BAR; PG8_SCHED;
            PG8_LDA(At, 0, 1); PG8_STAGE(PG8_SB(0, 0), b2, voffB); PG8_STAGE(PG8_SB(0, 1), b2 + hstepB, voffB); PG8_STAGE(PG8_SA(0, 0), a2, voffA);
            PG8_WAIT_V(8); PG8_WAIT_L(0); PG8_BAR; PG8_MMA(1, 0, At, B0); PG8_MMA(1, 1, At, B1); PG8_BAR; PG8_SCHED;
            PG8_LDB(B0, 1, 0); PG8_LDB(B1, 1, 1); PG8_SCHED; PG8_LDA(At, 1, 0); PG8_STAGE(PG8_SA(0, 1), a2 + hstepA, voffA);
            PG8_WAIT_V(8); PG8_WAIT_L(0); PG8_BAR; PG8_MMA(0, 0, At, B0); PG8_MMA(0, 1, At, B1); PG8_BAR; PG8_SCHED;
            PG8_LDA(At, 1, 1); PG8_STAGE(PG8_SB(1, 0), b3, voffB); PG8_STAGE(PG8_SB(1, 1), b3 + hstepB, voffB); PG8_STAGE(PG8_SA(1, 0), a3, voffA);
            PG8_WAIT_V(8); PG8_WAIT_L(0); PG8_BAR; PG8_MMA(1, 0, At, B0); PG8_MMA(1, 1, At, B1); PG8_BAR; PG8_SCHED;
        }
        if (wr == 0) PG8_BAR;
        cur.seq = ui; E(acc, cur, wr, wc, fr, fq);
        if (!has_next) break;
#pragma unroll
        for (int a = 0; a < 2; ++a)
#pragma unroll
            for (int b = 0; b < 2; ++b)
#pragma unroll
                for (int m = 0; m < 4; ++m)
#pragma unroll
                    for (int n = 0; n < 2; ++n) acc[a][b][m][n] = (f32x4){0.f, 0.f, 0.f, 0.f};
        cur = nxt; cA = nA; cB = nB; ++ui;
        if (wr == 1) PG8_BAR;
    }
    PG8_WAIT_V(0);
    PG8_BAR;
#undef PG8_SA
#undef PG8_SB
#undef PG8_STAGE
#undef PG8_LDA
#undef PG8_LDB
#undef PG8_MMA
#undef PG8_WAIT_V
#undef PG8_WAIT_L
#undef PG8_BAR
#undef PG8_SCHED
}
}

#define XB_TMO      128
#define XB_XCNT(j)  (256  + 64 * (j))
#define XB_XSUB(j)  (1280 + 64 * (j))
#define XB_XGEN(j)  (2304 + 64 * (j))
#define XB_TOP      3328
#define XB_TOPGEN   3392
#define XCD_BAR_WORDS 3456
#define XB_SPIN_CAP (1u << 18)
DI unsigned xb_ld(unsigned* p)              { return __hip_atomic_load(p, __ATOMIC_RELAXED, __HIP_MEMORY_SCOPE_AGENT); }
DI unsigned xb_add(unsigned* p, unsigned v) { return __hip_atomic_fetch_add(p, v, __ATOMIC_RELAXED, __HIP_MEMORY_SCOPE_AGENT); }
DI unsigned xb_xcc_id() { return (unsigned)__builtin_amdgcn_s_getreg((3 << 11) | 20) & 0xFu; }
#define XB_SPIN(cond, bar) do { unsigned _sp = 0; while (cond) { __builtin_amdgcn_s_sleep(1); \
    if ((++_sp & 255u) == 0u) { if (xb_ld(&(bar)[XB_TMO])) break; if (_sp > XB_SPIN_CAP) { atomicAdd(&(bar)[XB_TMO], 1u); break; } } } } while (0)
struct XcdBarrier { unsigned* bar; unsigned x; volatile LAS unsigned* st; };
DI XcdBarrier xcd_barrier_post(unsigned* bar, volatile LAS unsigned* st) {
    XcdBarrier b; b.bar = bar; b.x = xb_xcc_id(); b.st = st;
    if (threadIdx.x == 0) (void)xb_add(&bar[XB_XCNT(b.x)], 1u);
    return b;
}
DI void xcd_barrier_complete(unsigned* bar, unsigned x, unsigned& nloc, unsigned& nx) {
    const unsigned G = gridDim.x * gridDim.y * gridDim.z;
    unsigned sum, cnt, mine, sp = 0u;
    for (;;) {
        sum = 0u; cnt = 0u; mine = 0u;
#pragma unroll
        for (unsigned j = 0; j < 16; ++j) { const unsigned c = xb_ld(&bar[XB_XCNT(j)]); sum += c; cnt += (c > 0u) ? 1u : 0u; mine = (j == x) ? c : mine; }
        if (sum == G) break;
        __builtin_amdgcn_s_sleep(1);
        if ((++sp & 255u) == 0u) { if (xb_ld(&bar[XB_TMO])) break; if (sp > XB_SPIN_CAP) { atomicAdd(&bar[XB_TMO], 1u); break; } }
    }
    nloc = mine > 0u ? mine : 1u; nx = cnt > 0u ? cnt : 1u;
}
DI void xcd_barrier(const XcdBarrier& b) {
    asm volatile("s_waitcnt vmcnt(0)" ::: "memory");
    __syncthreads();
    if (threadIdx.x == 0) {
        unsigned* bar = b.bar;
        __builtin_amdgcn_s_waitcnt(0);
        unsigned nloc = b.st[0], nx = b.st[1];
        if (nloc == 0u) { xcd_barrier_complete(bar, b.x, nloc, nx); b.st[0] = nloc; b.st[1] = nx; }
        const unsigned old = xb_add(&bar[XB_XSUB(b.x)], 1u);
        const unsigned gen = old / nloc;
        if (old + 1u == (gen + 1u) * nloc) {
            __builtin_amdgcn_fence(__ATOMIC_RELEASE, "agent");
            asm volatile("s_waitcnt vmcnt(0)" ::: "memory");
            const unsigned og = xb_add(&bar[XB_TOP], 1u);
            const unsigned tg = og / nx;
            if (og + 1u == (tg + 1u) * nx) xb_add(&bar[XB_TOPGEN], 1u);
            else XB_SPIN(xb_ld(&bar[XB_TOPGEN]) == tg, bar);
            __builtin_amdgcn_fence(__ATOMIC_ACQUIRE, "agent");
            xb_add(&bar[XB_XGEN(b.x)], 1u);
            asm volatile("s_waitcnt vmcnt(0)" ::: "memory");
        } else {
            XB_SPIN(xb_ld(&bar[XB_XGEN(b.x)]) == gen, bar);
            __builtin_amdgcn_fence(__ATOMIC_ACQUIRE, "agent");
            asm volatile("s_waitcnt vmcnt(0)" ::: "memory");
        }
    }
    __syncthreads();
}

#define LDS_WAIT() asm volatile("s_waitcnt lgkmcnt(0)" ::: "memory")
DI float wave_sum(float v) {
#pragma unroll
    for (int o = 1; o < 64; o <<= 1) v += __shfl_xor(v, o);
    return v;
}
DI void tr_item(const float* W, size_t ldw, int col, int k0, bf16_t* dst, size_t dld, LAS float* scr, int lane) {
    float tv[32];
    { const float* wp0 = W + (size_t)(k0 + (lane >> 5)) * ldw + col + (lane & 31);
#pragma unroll
      for (int i = 0; i < 32; ++i) tv[i] = wp0[(size_t)(2 * i) * ldw]; }
#pragma unroll
    for (int i = 0; i < 32; ++i) { const int kk = 2 * i + (lane >> 5); scr[kk * 33 + (lane & 31)] = tv[i]; }
    LDS_WAIT(); asm volatile("" ::: "memory");
    const int c = lane & 7;
#pragma unroll
    for (int j = 0; j < 4; ++j) { const int n = (lane >> 3) + 8 * j; const LAS float* s = scr + (8 * c) * 33 + n;
        u32x4 o; o.x = pk_bf16(s[0 * 33], s[1 * 33]); o.y = pk_bf16(s[2 * 33], s[3 * 33]); o.z = pk_bf16(s[4 * 33], s[5 * 33]); o.w = pk_bf16(s[6 * 33], s[7 * 33]);
        *(u32x4*)(dst + (size_t)n * dld + 8 * c) = o; }
    LDS_WAIT(); asm volatile("" ::: "memory");
}
struct TrSrc { const float* src; bf16_t* dst; unsigned ldw, dld; };
DI void tr_load(float (&tv)[32], const TrSrc& t, int lane) {
    const float* wp0 = t.src + (size_t)(lane >> 5) * t.ldw + (lane & 31);
#pragma unroll
    for (int i = 0; i < 32; ++i) tv[i] = wp0[(size_t)(2 * i) * t.ldw];
}
DI void tr_store(const float (&tv)[32], const TrSrc& t, LAS float* scr, int lane) {
#pragma unroll
    for (int i = 0; i < 32; ++i) { const int kk = 2 * i + (lane >> 5); scr[kk * 33 + (lane & 31)] = tv[i]; }
    LDS_WAIT(); asm volatile("" ::: "memory");
    const int c = lane & 7;
#pragma unroll
    for (int j = 0; j < 4; ++j) { const int n = (lane >> 3) + 8 * j; const LAS float* s = scr + (8 * c) * 33 + n;
        u32x4 o; o.x = pk_bf16(s[0 * 33], s[1 * 33]); o.y = pk_bf16(s[2 * 33], s[3 * 33]); o.z = pk_bf16(s[4 * 33], s[5 * 33]); o.w = pk_bf16(s[6 * 33], s[7 * 33]);
        *(u32x4*)(t.dst + (size_t)n * t.dld + 8 * c) = o; }
    LDS_WAIT(); asm volatile("" ::: "memory");
}
template <class DEC> DI void tr_pipeline(DEC dec, int i0, int i1, int g, int NG, LAS float* scr, int lane) {
    int it = i0 + g;
    if (it >= i1) return;
    float A[32], B[32];
    TrSrc ta = dec(it), tb;
    tr_load(A, ta, lane);
    while (true) {
        int nx = it + NG; bool more = nx < i1;
        tb = dec(more ? nx : it); tr_load(B, tb, lane);
        tr_store(A, ta, scr, lane);
        if (!more) break;
        it = nx; nx = it + NG; more = nx < i1;
        ta = dec(more ? nx : it); tr_load(A, ta, lane);
        tr_store(B, tb, scr, lane);
        if (!more) break;
        it = nx;
    }
}
DI void rms_row_to_bf16(const float* xrow, const float* gain, bf16_t* orow, int lane) {
    const f32x4* xr = (const f32x4*)xrow + lane; const f32x4* gr = (const f32x4*)gain + lane;
    f32x4 v[8]; float s = 0.f;
#pragma unroll
    for (int j = 0; j < 8; ++j) { v[j] = xr[64 * j]; s += (v[j].x * v[j].x + v[j].y * v[j].y) + (v[j].z * v[j].z + v[j].w * v[j].w); }
    const float rstd = 1.0f / sqrtf(wave_sum(s) * (1.f / DM) + EPS);
    u32x2* o8 = (u32x2*)orow + lane;
#pragma unroll
    for (int j = 0; j < 8; ++j) { const f32x4 gg = gr[64 * j]; u32x2 w; w.x = pk_bf16(v[j].x * rstd * gg.x, v[j].y * rstd * gg.y); w.y = pk_bf16(v[j].z * rstd * gg.z, v[j].w * rstd * gg.w); o8[64 * j] = w; }
}

struct Args { const float* in[31]; float* out; unsigned char* ws; int ph_lo, ph_hi, li, pad; };
constexpr int ARGS_DW = sizeof(Args) / 4;
constexpr int LDSARGS_OFF = MISC_OFF + 128;
#ifndef GMASK
#define GMASK 866
#endif
template <class T> DI T* as_global(T* p) { return (T*)(__attribute__((address_space(1))) T*)(unsigned long long)p; }
template <bool GL = false> DI Args fetch_args(LAS unsigned char* lds) {
    Args a; unsigned* w = (unsigned*)&a; const LAS unsigned* la = (const LAS unsigned*)(lds + LDSARGS_OFF);
#pragma unroll
    for (int i = 0; i < ARGS_DW; ++i) w[i] = (unsigned)__builtin_amdgcn_readfirstlane((int)la[i]);
    if (GL) {
#pragma unroll
        for (int i = 0; i < 31; ++i) a.in[i] = as_global(a.in[i]);
        a.out = as_global(a.out); a.ws = as_global(a.ws); }
    return a;
}

DI void p0_prologue(const Args& a, LAS unsigned char* lds, int gw, int NGW, int wave, int lane) {
    LAS float* scr = (LAS float*)(lds + wave * 16384);
    unsigned char* ws = a.ws;
    bf16_t* RB = (bf16_t*)(ws + WS_RB); bf16_t* WBt = (bf16_t*)(ws + WS_WB);
    const float* w_in = a.in[12]; const float* w_gate = a.in[18];
    constexpr int J_U = 512, J_Q = 512, J_K = 512, J_V = 1024, J_R = 1024, J_MQ = 512, J_G = 6144, J_MK = 512, J_MV = 512, J_BG = 1024, J_BM = 512, J_VS = 2048, J_WC = 2048;
    constexpr int NTR = J_U + J_Q + J_K + J_V + J_R + J_MQ + J_G + J_MK + J_MV + J_BG + J_BM + J_VS + J_WC;
    constexpr int NROW = MTOK + NMEMROWS, NKS = 2048, NPAD = 240;
    constexpr int NITEMS = NTR + NROW + NKS + NPAD;
    constexpr int NTRP = J_U + J_Q + J_K + J_V + J_R + J_MQ + J_G + J_MK + J_MV + J_BG + J_BM + J_VS;
    {
        const float* gw_in = as_global(w_in); const float* gw_gate = as_global(w_gate); const float* gmk = as_global(a.in[9]); const float* gmv = as_global(a.in[10]);
        const float* gbg = as_global(a.in[21]); const float* gbm = as_global(a.in[22]); const float* gvs = as_global(a.in[7]); unsigned char* gws = as_global(ws);
        tr_pipeline([=](int r) -> TrSrc { TrSrc t; bf16_t* gRB = (bf16_t*)(gws + WS_RB); bf16_t* gWB = (bf16_t*)(gws + WS_WB);
#define TRJ(cnt, srcp, ldw_, col0, ncols, dstp) if (r < (cnt)) { const int nb = (ncols) / 32, kb = r / nb, n0 = (r % nb) * 32; \
                t.src = (srcp) + (size_t)(kb * 64) * (ldw_) + (col0) + n0; t.ldw = (ldw_); t.dst = (dstp) + (size_t)n0 * DM + kb * 64; t.dld = DM; return t; } r -= (cnt);
            TRJ(J_U, gw_in, INW, 0, 512, gRB + (size_t)(PN_W + WP_U) * 256 * DM)
            TRJ(J_Q, gw_in, INW, 512, 512, gRB + (size_t)(PN_W + WP_Q) * 256 * DM)
            TRJ(J_K, gw_in, INW, 1024, 512, gRB + (size_t)(PN_W + WP_K) * 256 * DM)
            TRJ(J_V, gw_in, INW, 1536, 1024, gRB + (size_t)(PN_W + WP_V) * 256 * DM)
            TRJ(J_R, gw_in, INW, 2560, 1024, gRB + (size_t)(PN_W + WP_R) * 256 * DM)
            TRJ(J_MQ, gw_in, INW, 3600, 512, gRB + (size_t)(PN_W + WP_MQ) * 256 * DM)
            TRJ(J_G, gw_gate, 6144, 0, 6144, gRB + (size_t)(PN_W + WP_G) * 256 * DM)
            TRJ(J_MK, gmk, 512, 0, 512, gRB + (size_t)(PN_W + WP_MK) * 256 * DM)
            TRJ(J_MV, gmv, 512, 0, 512, gRB + (size_t)(PN_W + WP_MV) * 256 * DM)
#undef TRJ
            if (r < J_BG) { const int kb = r / 64, n0 = (r % 64) * 32; t.src = gbg + (size_t)(kb * 64) * 2048 + n0; t.ldw = 2048; t.dst = gWB + (size_t)n0 * DM + 512 + kb * 64; t.dld = DM; return t; } r -= J_BG;
            if (r < J_BM) { const int kb = r / 64, n0 = (r % 64) * 32; t.src = gbm + (size_t)(kb * 64) * 2048 + n0; t.ldw = 2048; t.dst = gWB + (size_t)n0 * DM + 1536 + kb * 64; t.dld = DM; return t; } r -= J_BM;
            { const int kb = r / 16, n0 = (r % 16) * 32; t.src = gvs + (size_t)(kb * 64) * 512 + n0; t.ldw = 512; t.dst = (bf16_t*)(gws + WS_VST) + (size_t)n0 * 8192 + kb * 64; t.dld = 8192; return t; }
        }, 0, NTRP, gw, NGW, scr, lane);
    }
    {
        const float* gx0 = as_global(a.in[0]); const float* gx1 = as_global(a.in[1]); const float* gx2 = as_global(a.in[2]); const float* gg0 = as_global(a.in[11]); const float* gg1 = as_global(a.in[8]);
        bf16_t* gRB = (bf16_t*)(as_global(ws) + WS_RB);
        auto src = [&](int r) -> const float* { return r < NPROMPT ? gx0 + (size_t)r * DM : (r < MTOK ? gx1 + (size_t)(r - NPROMPT) * DM : gx2 + (size_t)(r - MTOK) * DM); };
        f32x4 nv[8];
        int r = gw;
        if (r < NROW) { const f32x4* xr = (const f32x4*)src(r) + lane;
#pragma unroll
            for (int j = 0; j < 8; ++j) nv[j] = xr[64 * j]; }
        for (; r < NROW; r += NGW) {
            f32x4 v[8]; float sq = 0.f;
#pragma unroll
            for (int j = 0; j < 8; ++j) { v[j] = nv[j]; sq += (v[j].x * v[j].x + v[j].y * v[j].y) + (v[j].z * v[j].z + v[j].w * v[j].w); }
            if (r + NGW < NROW) { const f32x4* xr = (const f32x4*)src(r + NGW) + lane;
#pragma unroll
                for (int j = 0; j < 8; ++j) nv[j] = xr[64 * j]; }
            const float rstd = 1.0f / sqrtf(wave_sum(sq) * (1.f / DM) + EPS);
            const f32x4* gr = (const f32x4*)(r < MTOK ? gg0 : gg1) + lane;
            u32x2* o8 = (u32x2*)(gRB + (size_t)(r < MTOK ? r : PN_MN * 256 + (r - MTOK)) * DM) + lane;
#pragma unroll
            for (int j = 0; j < 8; ++j) { const f32x4 gq = gr[64 * j]; u32x2 w; w.x = pk_bf16(v[j].x * rstd * gq.x, v[j].y * rstd * gq.y); w.y = pk_bf16(v[j].z * rstd * gq.z, v[j].w * rstd * gq.w); o8[64 * j] = w; }
        }
    }
    for (int r = gw; r < J_WC; r += NGW) {
        const int g = r >> 9, cb = (r >> 5) & 15, nb = r & 31, n = nb * 64 + lane;
        const float* wp = a.in[13] + ((size_t)g * 128 + cb * 8) * 128; const float* sp = a.in[14] + g * 128; const float* wb = a.in[20] + (size_t)g * 128 * DM + n;
        f32x4 wq[4]; float sq[2];
#pragma unroll
        for (int k = 0; k < 4; ++k) wq[k] = ((const f32x4*)wp)[lane + 64 * k];
        sq[0] = sp[lane]; sq[1] = sp[64 + lane];
        float acc8[8];
#pragma unroll
        for (int i = 0; i < 8; ++i) acc8[i] = 0.f;
#pragma unroll
        for (int h2 = 0; h2 < 4; ++h2) {
            float xb[32];
#pragma unroll
            for (int d = 0; d < 32; ++d) xb[d] = wb[(size_t)(32 * h2 + d) * DM];
#pragma unroll
            for (int dd = 0; dd < 32; ++dd) { const int d = 32 * h2 + dd;
                const float x = xb[dd] * __int_as_float(__builtin_amdgcn_readlane(__float_as_int(sq[d >> 6]), d & 63));
#pragma unroll
                for (int i = 0; i < 8; ++i) { const int e = i * 128 + d;
                    acc8[i] += __int_as_float(__builtin_amdgcn_readlane(__float_as_int(wq[e >> 8][e & 3]), (e >> 2) & 63)) * x; } }
        }
        u32x4 o; o.x = pk_bf16(acc8[0], acc8[1]); o.y = pk_bf16(acc8[2], acc8[3]); o.z = pk_bf16(acc8[4], acc8[5]); o.w = pk_bf16(acc8[6], acc8[7]);
        *(u32x4*)(WBt + (size_t)n * DM + g * 128 + cb * 8) = o;
    }
    for (int it = NTRP + gw; it < NITEMS; it += NGW) {
        int r = it - NTRP;
        if (r < J_WC) continue;
        r -= J_WC;
        if (r < NROW) continue;
        r -= NROW;
        if (r < NKS) {
            const f32x4* s = (const f32x4*)(a.in[6] + (size_t)r * 2048) + lane; u32x2* d = (u32x2*)((bf16_t*)(ws + WS_KS) + (size_t)r * 2048) + lane;
#pragma unroll
            for (int j = 0; j < 8; ++j) { const f32x4 v = s[64 * j]; u32x2 w; w.x = pk_bf16(v.x, v.y); w.y = pk_bf16(v.z, v.w); d[64 * j] = w; }
            continue; } r -= NKS;
        {
            bf16_t* P = RB + (size_t)(PN_W + WP_ALR) * 256 * DM;
            u32x4 z = {0u, 0u, 0u, 0u}; u32x4* d = (u32x4*)(P + (size_t)(16 + r) * DM) + lane;
#pragma unroll
            for (int j = 0; j < 4; ++j) d[64 * j] = z;
            if (r < 16) {
                float tc[32];
#pragma unroll
                for (int j2 = 0; j2 < 32; ++j2) tc[j2] = w_in[(size_t)(lane + 64 * j2) * INW + 3584 + r];
#pragma unroll
                for (int j2 = 0; j2 < 32; ++j2) P[(size_t)r * DM + lane + 64 * j2] = (bf16_t)(pk_bf16(tc[j2], 0.f) & 0xffffu); }
        }
    }
}

DI void pool_item(const Args& a, int item, int lane) {
    const float* U = (const float*)(a.ws + WS_U); bf16_t* BR = (bf16_t*)(a.ws + WS_BR);
    const int w = 2 << (lane >> 4), c0 = lane * 8, m0 = item * 8;
    int t0, T, seq0; const float* hist = nullptr; float* po;
    if (m0 < NPROMPT) { t0 = m0 & 4095; T = 4096; seq0 = m0 - t0; po = a.out + O_POOLP + (size_t)(m0 >> 12) * 15 * 512; }
    else { t0 = (m0 - NPROMPT) & 31; T = 32; seq0 = m0 - t0; const int b = (m0 - NPROMPT) >> 5; hist = a.in[3] + (size_t)b * 15 * 512; po = a.out + O_POOLS + (size_t)b * 15 * 512; }
    auto rowp = [&](int tt) -> const float* { return tt >= 0 ? U + (size_t)(seq0 + tt) * 512 + c0 : ((hist && tt >= -15) ? hist + (size_t)(15 + tt) * 512 + c0 : nullptr); };
    const f32x4 z4 = {0.f, 0.f, 0.f, 0.f};
    f32x4 x0[8], x1[8], y0[8], y1[8];
#pragma unroll
    for (int i = 0; i < 8; ++i) { const float* p = rowp(t0 + i); x0[i] = *(const f32x4*)p; x1[i] = *(const f32x4*)(p + 4);
        const float* q = rowp(t0 + i - w); if (q) { y0[i] = *(const f32x4*)q; y1[i] = *(const f32x4*)(q + 4); } else { y0[i] = z4; y1[i] = z4; } }
    f32x4 s0 = z4, s1 = z4;
#pragma unroll
    for (int j = 1; j <= 16; ++j) { if (j <= w) { const float* p = rowp(t0 - j); if (p) { s0 += *(const f32x4*)p; s1 += *(const f32x4*)(p + 4); } } }
#pragma unroll
    for (int i = 0; i < 8; ++i) {
        const int t = t0 + i, m = m0 + i;
        s0 += x0[i] - y0[i]; s1 += x1[i] - y1[i];
        const float cnt = hist ? (float)w : (float)((t + 1) < w ? (t + 1) : w), ic = 1.0f / cnt;
        const f32x4 d0 = s0 * ic - x0[i], d1 = s1 * ic - x1[i];
        *(u32x4*)(BR + (size_t)m * DM + c0) = pack8(d0, d1);
        if (t >= T - 15) { float* q = po + (size_t)(t - (T - 15)) * 512 + c0; *(f32x4*)q = x0[i]; *(f32x4*)(q + 4) = x1[i]; }
    }
}

DI void mem_attn_item(const Args& a, int item, int lane) {
    const int r32 = lane & 31, hh = lane >> 5;
    const bf16_t* MQ = (const bf16_t*)(a.ws + WS_MQ); bf16_t* BR = (bf16_t*)(a.ws + WS_BR);
    int m0, h; const bf16_t* Kb; const bf16_t* VT; size_t ldv;
    if (item < 2048) { const int b = item >> 9, rem = item & 511; h = rem >> 7; m0 = b * 4096 + (rem & 127) * 32;
        Kb = (const bf16_t*)(a.ws + WS_KM) + (size_t)b * 256 * 512 + h * 128; VT = (const bf16_t*)(a.ws + WS_VMT) + (size_t)h * 128 * 1024 + b * 256; ldv = 1024; }
    else { const int j = item - 2048, b = j >> 2; h = j & 3; m0 = NPROMPT + b * 32;
        Kb = (const bf16_t*)(a.ws + WS_KS) + (size_t)b * 256 * 512 + h * 128; VT = (const bf16_t*)(a.ws + WS_VST) + (size_t)h * 128 * 8192 + b * 256; ldv = 8192; }
    bf16x8 qf[8];
#pragma unroll
    for (int s = 0; s < 8; ++s) qf[s] = *(const bf16x8*)(MQ + (size_t)(m0 + r32) * 512 + h * 128 + 16 * s + 8 * hh);
    f32x16 sc[8];
    bf16x8 kA[4], kB[4];
#pragma unroll
    for (int s = 0; s < 4; ++s) kA[s] = *(const bf16x8*)(Kb + (size_t)r32 * 512 + 16 * s + 8 * hh);
    f32x16 c;
#pragma unroll
    for (int g = 0; g < 16; ++g) {
        const int kt = g >> 1, sg = g & 1;
        if (sg == 0) {
#pragma unroll
            for (int i = 0; i < 16; ++i) c[i] = 0.f; }
        if (g + 1 < 16) { const int kt1 = (g + 1) >> 1, sg1 = (g + 1) & 1;
#pragma unroll
            for (int s = 0; s < 4; ++s) { const bf16x8 v = *(const bf16x8*)(Kb + (size_t)(32 * kt1 + r32) * 512 + 16 * (4 * sg1 + s) + 8 * hh); if (g & 1) kA[s] = v; else kB[s] = v; } }
        asm volatile("" ::: "memory");
#pragma unroll
        for (int s = 0; s < 4; ++s) c = __builtin_amdgcn_mfma_f32_32x32x16_bf16((g & 1) ? kB[s] : kA[s], qf[4 * sg + s], c, 0, 0, 0);
        if (sg == 1) sc[kt] = c;
    }
    float mx = -3.0e38f;
#pragma unroll
    for (int kt = 0; kt < 8; ++kt)
#pragma unroll
        for (int i = 0; i < 16; ++i) mx = fmaxf(mx, sc[kt][i]);
    mx = fmaxf(mx, __shfl_xor(mx, 32));
    float l = 0.f;
    bf16x8 pf[8][2];
#pragma unroll
    for (int kt = 0; kt < 8; ++kt) {
        float p[16];
#pragma unroll
        for (int i = 0; i < 16; ++i) { p[i] = __builtin_amdgcn_exp2f(sc[kt][i] - mx); l += p[i]; }
#pragma unroll
        for (int s = 0; s < 2; ++s) { u32x4 w; w.x = pk_bf16(p[8 * s], p[8 * s + 1]); w.y = pk_bf16(p[8 * s + 2], p[8 * s + 3]); w.z = pk_bf16(p[8 * s + 4], p[8 * s + 5]); w.w = pk_bf16(p[8 * s + 6], p[8 * s + 7]);
            pf[kt][s] = __builtin_bit_cast(bf16x8, w); }
    }
    l += __shfl_xor(l, 32);
    const float il = 1.0f / l;
#pragma unroll
    for (int dt = 0; dt < 4; ++dt) {
        f32x16 o;
#pragma unroll
        for (int i = 0; i < 16; ++i) o[i] = 0.f;
        const bf16_t* vr = VT + (size_t)(32 * dt + r32) * ldv + 4 * hh;
#pragma unroll
        for (int kt = 0; kt < 8; ++kt)
#pragma unroll
            for (int s = 0; s < 2; ++s) {
                const s16x4 lo = *(const s16x4*)(vr + 32 * kt + 16 * s), hi = *(const s16x4*)(vr + 32 * kt + 16 * s + 8);
                const bf16x8 vf = __builtin_shufflevector(lo, hi, 0, 1, 2, 3, 4, 5, 6, 7);
                o = __builtin_amdgcn_mfma_f32_32x32x16_bf16(vf, pf[kt][s], o, 0, 0, 0);
            }
        bf16_t* op = BR + (size_t)(m0 + r32) * DM + 1536 + h * 128 + 32 * dt + 4 * hh;
#pragma unroll
        for (int g = 0; g < 4; ++g) { u32x2 w; w.x = pk_bf16(o[4 * g] * il, o[4 * g + 1] * il); w.y = pk_bf16(o[4 * g + 2] * il, o[4 * g + 3] * il); *(u32x2*)(op + 8 * g) = w; }
    }
}
constexpr int MA_K = 0, MA_KSTR = 272, MA_V1 = 256 * MA_KSTR, MA_VSTR = 520, MA_VROWS1 = (131072 - MA_V1) / MA_VSTR, MA_V2 = 131072 + 1024;
DI void mem_attn_core(const Args& a, LAS unsigned char* lds, const bf16_t* Kb, const bf16_t* VT, int ldv, int m0, int h, int lane, bool compute) {
    const int tid = threadIdx.x, r32 = lane & 31, hh = lane >> 5;
    const bf16_t* MQ = (const bf16_t*)(a.ws + WS_MQ); bf16_t* BR = (bf16_t*)(a.ws + WS_BR);
    bf16x8 qf[8];
#pragma unroll
    for (int s = 0; s < 8; ++s) qf[s] = *(const bf16x8*)(MQ + (size_t)(m0 + r32) * 512 + h * 128 + 16 * s + 8 * hh);
    {
        u32x4 kp[8], vp[8];
#pragma unroll
        for (int k = 0; k < 8; ++k) { const int p = tid + 512 * k; kp[k] = *(const u32x4*)(Kb + (size_t)(p >> 4) * 512 + (p & 15) * 8); vp[k] = *(const u32x4*)(VT + (size_t)(p >> 5) * ldv + (p & 31) * 8); }
        __syncthreads();
#pragma unroll
        for (int k = 0; k < 8; ++k) { const int p = tid + 512 * k; *(LAS u32x4*)(lds + MA_K + (p >> 4) * MA_KSTR + (p & 15) * 16) = kp[k];
            const int vr = p >> 5; LAS unsigned char* vb = (vr < MA_VROWS1) ? lds + MA_V1 + vr * MA_VSTR : lds + MA_V2 + (vr - MA_VROWS1) * MA_VSTR;
            LAS unsigned* vd = (LAS unsigned*)(vb + (p & 31) * 16); vd[0] = vp[k].x; vd[1] = vp[k].y; vd[2] = vp[k].z; vd[3] = vp[k].w; }
        LDS_WAIT(); __syncthreads();
    }
    if (!compute) return;
    f32x16 sc[8];
#pragma unroll
    for (int kt = 0; kt < 8; ++kt) { f32x16 c;
#pragma unroll
        for (int i = 0; i < 16; ++i) c[i] = 0.f;
#pragma unroll
        for (int s = 0; s < 8; ++s) { const bf16x8 kf = *(const LAS bf16x8*)(lds + MA_K + (32 * kt + r32) * MA_KSTR + (16 * s + 8 * hh) * 2); c = __builtin_amdgcn_mfma_f32_32x32x16_bf16(kf, qf[s], c, 0, 0, 0); }
        sc[kt] = c; }
    float mx = -3.0e38f;
#pragma unroll
    for (int kt = 0; kt < 8; ++kt)
#pragma unroll
        for (int i = 0; i < 16; ++i) mx = fmaxf(mx, sc[kt][i]);
    mx = fmaxf(mx, __shfl_xor(mx, 32));
    float l = 0.f;
    bf16x8 pf[8][2];
#pragma unroll
    for (int kt = 0; kt < 8; ++kt) {
        float p[16];
#pragma unroll
        for (int i = 0; i < 16; ++i) { p[i] = __builtin_amdgcn_exp2f(sc[kt][i] - mx); l += p[i]; }
#pragma unroll
        for (int s = 0; s < 2; ++s) { u32x4 w; w.x = pk_bf16(p[8 * s], p[8 * s + 1]); w.y = pk_bf16(p[8 * s + 2], p[8 * s + 3]); w.z = pk_bf16(p[8 * s + 4], p[8 * s + 5]); w.w = pk_bf16(p[8 * s + 6], p[8 * s + 7]);
            pf[kt][s] = __builtin_bit_cast(bf16x8, w); }
    }
    l += __shfl_xor(l, 32);
    const float il = 1.0f / l;
#pragma unroll
    for (int dt = 0; dt < 4; ++dt) {
        f32x16 o;
#pragma unroll
        for (int i = 0; i < 16; ++i) o[i] = 0.f;
        const int vrow = 32 * dt + r32; const LAS unsigned char* vr = ((vrow < MA_VROWS1) ? lds + MA_V1 + vrow * MA_VSTR : lds + MA_V2 + (vrow - MA_VROWS1) * MA_VSTR) + 8 * hh;
#pragma unroll
        for (int kt = 0; kt < 8; ++kt)
#pragma unroll
            for (int s = 0; s < 2; ++s) {
                const s16x4 lo = *(const LAS s16x4*)(vr + (32 * kt + 16 * s) * 2), hi = *(const LAS s16x4*)(vr + (32 * kt + 16 * s + 8) * 2);
                const bf16x8 vf = __builtin_shufflevector(lo, hi, 0, 1, 2, 3, 4, 5, 6, 7);
                o = __builtin_amdgcn_mfma_f32_32x32x16_bf16(vf, pf[kt][s], o, 0, 0, 0);
            }
        bf16_t* op = BR + (size_t)(m0 + r32) * DM + 1536 + h * 128 + 32 * dt + 4 * hh;
#pragma unroll
        for (int g = 0; g < 4; ++g) { u32x2 w; w.x = pk_bf16(o[4 * g] * il, o[4 * g + 1] * il); w.y = pk_bf16(o[4 * g + 2] * il, o[4 * g + 3] * il); *(u32x2*)(op + 8 * g) = w; }
    }
}
DI void mem_attn_wg(const Args& a, LAS unsigned char* lds, int item, int lane) {
    const int b = item >> 9, rem = item & 511, h = rem >> 7, m0 = b * 4096 + (rem & 127) * 32;
    mem_attn_core(a, lds, (const bf16_t*)(a.ws + WS_KM) + (size_t)b * 256 * 512 + h * 128, (const bf16_t*)(a.ws + WS_VMT) + (size_t)h * 128 * 1024 + b * 256, 1024, m0, h, lane, true);
}
DI void mem_attn_wg_sample(const Args& a, LAS unsigned char* lds, int j, int wave, int lane) {
    const int b = j >> 2, h = j & 3;
    mem_attn_core(a, lds, (const bf16_t*)(a.ws + WS_KS) + (size_t)b * 256 * 512 + h * 128, (const bf16_t*)(a.ws + WS_VST) + (size_t)h * 128 * 8192 + b * 256, 8192, NPROMPT + b * 32, h, lane, wave == 0);
}

constexpr int GL_QE = 0, GL_KE = 17408, GL_KT = 34816, GL_AT = 53248, GL_BL = 62464, GL_QP = 95232, GL_DEC = 97280, GL_SSQ = 97792, GL_RSTD = 99840, GL_ALR = 100096, GL_WG = 104192;
DI int crow(int reg, int hh) { return (reg & 3) + 8 * (reg >> 2) + 4 * hh; }
template <int CT>
DI void gla_sequence(const Args& a, LAS unsigned char* lds, int tok0, int nchunks, int h, const float* s_in, float* s_out) {
    const int tid = threadIdx.x, w = __builtin_amdgcn_readfirstlane(tid >> 6), lane = tid & 63, r32 = lane & 31, hh = lane >> 5;
    constexpr int QR = CT / 4, NTT = CT / 32, NKS = CT / 16;
    const bf16_t* Qg = (const bf16_t*)(a.ws + WS_Q); const bf16_t* Kg = (const bf16_t*)(a.ws + WS_K); const float* ALRg = (const float*)(a.ws + WS_ALR);
    const bf16_t* VRT = (const bf16_t*)(a.ws + WS_VRT); bf16_t* BR = (bf16_t*)(a.ws + WS_BR);
    const int vcol = h * 256 + 32 * w + r32;
    const bf16_t* vrow = VRT + (size_t)vcol * MTOK; const bf16_t* rrow = VRT + (size_t)(1024 + vcol) * MTOK;
    const float ghead = a.in[17][vcol];
    const int c1 = tid & 127, tq = tid >> 7, t2 = tid >> 3, c0 = (tid & 7) * 16;
    for (int i = tid; i < 16 * 128; i += 512) *(LAS float*)(lds + GL_WG + i * 4) = a.in[15][(size_t)(i >> 7) * 512 + h * 128 + (i & 127)];
    const float bgc = a.in[16][h * 128 + c1];
    f32x16 S[4];
#pragma unroll
    for (int kt = 0; kt < 4; ++kt)
#pragma unroll
        for (int i = 0; i < 16; ++i) S[kt][i] = s_in ? s_in[(size_t)(32 * kt + crow(i, hh)) * 256 + 32 * w + r32] : 0.f;
    f32x4 an = {0.f, 0.f, 0.f, 0.f};
    if (tid < CT * 4) { an = *(const f32x4*)(ALRg + (size_t)(tok0 + (tid >> 2)) * 16 + (tid & 3) * 4); *(LAS f32x4*)(lds + GL_ALR + tid * 16) = an; }
    LDS_WAIT(); __syncthreads();
    for (int n = 0; n < nchunks; ++n) {
        const int t0 = tok0 + n * CT;
        bf16x8 qc[2] = {}, kc[2] = {}, vf[NKS];
        if (t2 < CT) { const size_t o = (size_t)(t0 + t2) * 512 + h * 128 + c0; qc[0] = *(const bf16x8*)(Qg + o); qc[1] = *(const bf16x8*)(Qg + o + 8); kc[0] = *(const bf16x8*)(Kg + o); kc[1] = *(const bf16x8*)(Kg + o + 8); }
#pragma unroll
        for (int s = 0; s < NKS; ++s) vf[s] = *(const bf16x8*)(vrow + t0 + 16 * s + 8 * hh);
        if (n + 1 < nchunks && tid < CT * 4) an = *(const f32x4*)(ALRg + (size_t)(t0 + CT + (tid >> 2)) * 16 + (tid & 3) * 4);
        {
            float run = 0.f;
#pragma unroll 4
            for (int i = 0; i < QR; ++i) { const int t = tq * QR + i; const LAS f32x4* ar = (const LAS f32x4*)(lds + GL_ALR + t * 64);
                float pre = bgc;
#pragma unroll
                for (int j4 = 0; j4 < 4; ++j4) { const f32x4 x = ar[j4]; const LAS float* wgp = (const LAS float*)(lds + GL_WG + (4 * j4 * 128 + c1) * 4); pre += x[0] * wgp[0] + x[1] * wgp[128] + x[2] * wgp[256] + x[3] * wgp[384]; }
                const float ls = fminf(pre, 0.f) - __logf(1.0f + __expf(-fabsf(pre)));
                run += ls * (1.0f / 16.0f);
                *(LAS float*)(lds + GL_BL + (t * 128 + c1) * 4) = run; }
            *(LAS float*)(lds + GL_QP + (tq * 128 + c1) * 4) = run;
        }
        LDS_WAIT(); __syncthreads();
        if (t2 < CT) {
            const int tqr = t2 / QR;
#pragma unroll
            for (int half = 0; half < 2; ++half) {
                float bl[8], bb[8];
#pragma unroll
                for (int i = 0; i < 8; ++i) { bl[i] = 0.f; bb[i] = 0.f; }
#pragma unroll
                for (int q4 = 0; q4 < 4; ++q4) {
                    const LAS f32x4* qp = (const LAS f32x4*)(lds + GL_QP + (q4 * 128 + c0 + 8 * half) * 4); const f32x4 x0 = qp[0], x1 = qp[1];
#pragma unroll
                    for (int i = 0; i < 4; ++i) { bl[i] += x0[i]; bl[4 + i] += x1[i]; if (q4 < tqr) { bb[i] += x0[i]; bb[4 + i] += x1[i]; } }
                }
                { const LAS f32x4* bp = (const LAS f32x4*)(lds + GL_BL + (t2 * 128 + c0 + 8 * half) * 4); const f32x4 x0 = bp[0], x1 = bp[1];
#pragma unroll
                  for (int i = 0; i < 4; ++i) { bb[i] += x0[i]; bb[4 + i] += x1[i]; } }
                float qe[8], ke[8], kt[8];
#pragma unroll
                for (int i = 0; i < 8; ++i) { const float qv = bf2f((bf16_t)qc[half][i]), kv = bf2f((bf16_t)kc[half][i]);
                    qe[i] = qv * 0.08838834764831845f * __expf(bb[i]); ke[i] = kv * __expf(-bb[i]); kt[i] = kv * __expf(bl[i] - bb[i]); }
                u32x4 wq, wk; wq.x = pk_bf16(qe[0], qe[1]); wq.y = pk_bf16(qe[2], qe[3]); wq.z = pk_bf16(qe[4], qe[5]); wq.w = pk_bf16(qe[6], qe[7]);
                wk.x = pk_bf16(ke[0], ke[1]); wk.y = pk_bf16(ke[2], ke[3]); wk.z = pk_bf16(ke[4], ke[5]); wk.w = pk_bf16(ke[6], ke[7]);
                *(LAS u32x4*)(lds + GL_QE + t2 * 272 + (c0 + 8 * half) * 2) = wq;
                *(LAS u32x4*)(lds + GL_KE + t2 * 272 + (c0 + 8 * half) * 2) = wk;
#pragma unroll
                for (int i = 0; i < 8; i += 2) { const unsigned pw = pk_bf16(kt[i], kt[i + 1]);
                    *(LAS bf16_t*)(lds + GL_KT + (c0 + 8 * half + i) * 144 + t2 * 2) = (bf16_t)(pw & 0xffffu);
                    *(LAS bf16_t*)(lds + GL_KT + (c0 + 8 * half + i + 1) * 144 + t2 * 2) = (bf16_t)(pw >> 16); }
                if (t2 == CT - 1) {
#pragma unroll
                    for (int i = 0; i < 8; ++i) *(LAS float*)(lds + GL_DEC + (c0 + 8 * half + i) * 4) = __expf(bl[i]); }
            }
        }
        LDS_WAIT(); __syncthreads();
        if (w < (NTT == 2 ? 3 : 1)) {
            const int ti = (w == 0) ? 0 : 1, tj = (w == 2) ? 1 : 0;
            f32x16 c;
#pragma unroll
            for (int i = 0; i < 16; ++i) c[i] = 0.f;
#pragma unroll
            for (int s = 0; s < 8; ++s) {
                const bf16x8 af = *(const LAS bf16x8*)(lds + GL_QE + (32 * ti + r32) * 272 + (16 * s + 8 * hh) * 2);
                const bf16x8 bfr = *(const LAS bf16x8*)(lds + GL_KE + (32 * tj + r32) * 272 + (16 * s + 8 * hh) * 2);
                c = __builtin_amdgcn_mfma_f32_32x32x16_bf16(af, bfr, c, 0, 0, 0);
            }
            const int tcol = 32 * tj + r32;
#pragma unroll
            for (int i = 0; i < 16; i += 2) { const int tr0 = 32 * ti + crow(i, hh), tr1 = tr0 + 1;
                const unsigned pw = pk_bf16(tcol <= tr0 ? c[i] : 0.f, tcol <= tr1 ? c[i + 1] : 0.f);
                *(LAS bf16_t*)(lds + GL_AT + tr0 * 144 + tcol * 2) = (bf16_t)(pw & 0xffffu);
                *(LAS bf16_t*)(lds + GL_AT + tr1 * 144 + tcol * 2) = (bf16_t)(pw >> 16); }
        }
        LDS_WAIT(); __syncthreads();
        f32x16 o[NTT];
#pragma unroll
        for (int tt = 0; tt < NTT; ++tt) {
            f32x16 c;
#pragma unroll
            for (int i = 0; i < 16; ++i) c[i] = 0.f;
#pragma unroll
            for (int s = 0; s < 2 * (tt + 1); ++s) {
                const bf16x8 af = *(const LAS bf16x8*)(lds + GL_AT + (32 * tt + r32) * 144 + (16 * s + 8 * hh) * 2);
                c = __builtin_amdgcn_mfma_f32_32x32x16_bf16(af, vf[s], c, 0, 0, 0);
            }
#pragma unroll
            for (int kt = 0; kt < 4; ++kt)
#pragma unroll
                for (int s = 0; s < 2; ++s) {
                    u32x4 pw; pw.x = pk_bf16(S[kt][8 * s], S[kt][8 * s + 1]); pw.y = pk_bf16(S[kt][8 * s + 2], S[kt][8 * s + 3]); pw.z = pk_bf16(S[kt][8 * s + 4], S[kt][8 * s + 5]); pw.w = pk_bf16(S[kt][8 * s + 6], S[kt][8 * s + 7]);
                    const bf16x8 sf = __builtin_bit_cast(bf16x8, pw);
                    const LAS unsigned char* qa = lds + GL_QE + (32 * tt + r32) * 272 + (32 * kt + 16 * s + 4 * hh) * 2;
                    const s16x4 lo = *(const LAS s16x4*)qa, hi = *(const LAS s16x4*)(qa + 16);
                    const bf16x8 af = __builtin_shufflevector(lo, hi, 0, 1, 2, 3, 4, 5, 6, 7);
                    c = __builtin_amdgcn_mfma_f32_32x32x16_bf16(af, sf, c, 0, 0, 0);
                }
            o[tt] = c;
        }
#pragma unroll
        for (int tt = 0; tt < NTT; ++tt) {
            float x[16];
#pragma unroll
            for (int i = 0; i < 16; ++i) x[i] = o[tt][i] * o[tt][i];
#pragma unroll
            for (int i = 0; i < 8; ++i) { const bool up = (lane & 16) != 0; const float keep = up ? x[i + 8] : x[i], send = up ? x[i] : x[i + 8]; x[i] = keep + __shfl_xor(send, 16); }
#pragma unroll
            for (int i = 0; i < 4; ++i) { const bool up = (lane & 8) != 0; const float keep = up ? x[i + 4] : x[i], send = up ? x[i] : x[i + 4]; x[i] = keep + __shfl_xor(send, 8); }
#pragma unroll
            for (int i = 0; i < 2; ++i) { const bool up = (lane & 4) != 0; const float keep = up ? x[i + 2] : x[i], send = up ? x[i] : x[i + 2]; x[i] = keep + __shfl_xor(send, 4); }
            { const bool up = (lane & 2) != 0; const float keep = up ? x[1] : x[0], send = up ? x[0] : x[1]; x[0] = keep + __shfl_xor(send, 2); }
            x[0] += __shfl_xor(x[0], 1);
            if ((lane & 1) == 0) { const int reg = (r32 >> 1) & 15; *(LAS float*)(lds + GL_SSQ + (w * 64 + 32 * tt + crow(reg, hh)) * 4) = x[0]; }
        }
        LDS_WAIT(); __syncthreads();
        if (tid < CT) { float s = 0.f;
#pragma unroll
            for (int ww = 0; ww < 8; ++ww) s += *(const LAS float*)(lds + GL_SSQ + (ww * 64 + tid) * 4);
            *(LAS float*)(lds + GL_RSTD + tid * 4) = 1.0f / sqrtf(s * (1.0f / 256.0f) + EPS); }
        LDS_WAIT(); __syncthreads();
#pragma unroll
        for (int tt = 0; tt < NTT; ++tt)
#pragma unroll
            for (int g4 = 0; g4 < 4; ++g4) {
                const int tb = 32 * tt + 8 * g4 + 4 * hh;
                const u32x2 rw = *(const u32x2*)(rrow + t0 + tb);
                const float rv[4] = {bf_lo(rw.x), bf_hi(rw.x), bf_lo(rw.y), bf_hi(rw.y)};
#pragma unroll
                for (int e = 0; e < 4; ++e) { const float rs = *(const LAS float*)(lds + GL_RSTD + (tb + e) * 4);
                    const float val = o[tt][4 * g4 + e] * rs * ghead * rv[e];
                    BR[(size_t)(t0 + tb + e) * DM + 512 + vcol] = (bf16_t)(pk_bf16(val, 0.f) & 0xffffu); }
            }
#pragma unroll
        for (int kt = 0; kt < 4; ++kt) {
#pragma unroll
            for (int i = 0; i < 16; ++i) S[kt][i] *= *(const LAS float*)(lds + GL_DEC + (32 * kt + crow(i, hh)) * 4);
#pragma unroll
            for (int s = 0; s < NKS; ++s) {
                const bf16x8 af = *(const LAS bf16x8*)(lds + GL_KT + (32 * kt + r32) * 144 + (16 * s + 8 * hh) * 2);
                S[kt] = __builtin_amdgcn_mfma_f32_32x32x16_bf16(af, vf[s], S[kt], 0, 0, 0);
            }
        }
        if (n + 1 < nchunks && tid < CT * 4) *(LAS f32x4*)(lds + GL_ALR + tid * 16) = an;
        LDS_WAIT(); __syncthreads();
    }
#pragma unroll
    for (int kt = 0; kt < 4; ++kt)
#pragma unroll
        for (int i = 0; i < 16; ++i) s_out[(size_t)(32 * kt + crow(i, hh)) * 256 + 32 * w + r32] = S[kt][i];
}

DI void gla_prep_chunk(const Args& a, LAS unsigned char* lds, int t0, int h) {
    constexpr int CT = 64, QR = 16;
    const int tid = threadIdx.x, w = __builtin_amdgcn_readfirstlane(tid >> 6), lane = tid & 63, r32 = lane & 31, hh = lane >> 5;
    bf16_t* Qg = (bf16_t*)(a.ws + WS_Q); bf16_t* Kg = (bf16_t*)(a.ws + WS_K); const float* ALRg = (const float*)(a.ws + WS_ALR); bf16_t* BR = (bf16_t*)(a.ws + WS_BR);
    const int c1 = tid & 127, tq = tid >> 7, t2 = tid >> 3, c0 = (tid & 7) * 16;
    const float bgc = a.in[16][h * 128 + c1];
    bf16x8 qc[2], kc[2];
    { const size_t o = (size_t)(t0 + t2) * 512 + h * 128 + c0; qc[0] = *(const bf16x8*)(Qg + o); qc[1] = *(const bf16x8*)(Qg + o + 8); kc[0] = *(const bf16x8*)(Kg + o); kc[1] = *(const bf16x8*)(Kg + o + 8); }
    if (tid < CT * 4) *(LAS f32x4*)(lds + GL_ALR + tid * 16) = *(const f32x4*)(ALRg + (size_t)(t0 + (tid >> 2)) * 16 + (tid & 3) * 4);
    LDS_WAIT(); __syncthreads();
    {
        float run = 0.f;
#pragma unroll 4
        for (int i = 0; i < QR; ++i) { const int t = tq * QR + i; const LAS f32x4* ar = (const LAS f32x4*)(lds + GL_ALR + t * 64);
            float pre = bgc;
#pragma unroll
            for (int j4 = 0; j4 < 4; ++j4) { const f32x4 x = ar[j4]; const LAS float* wgp = (const LAS float*)(lds + GL_WG + (4 * j4 * 128 + c1) * 4); pre += x[0] * wgp[0] + x[1] * wgp[128] + x[2] * wgp[256] + x[3] * wgp[384]; }
            const float ls = fminf(pre, 0.f) - __logf(1.0f + __expf(-fabsf(pre)));
            run += ls * (1.0f / 16.0f);
            *(LAS float*)(lds + GL_BL + (t * 128 + c1) * 4) = run; }
        *(LAS float*)(lds + GL_QP + (tq * 128 + c1) * 4) = run;
    }
    LDS_WAIT(); __syncthreads();
    {
        const int tqr = t2 / QR;
#pragma unroll
        for (int half = 0; half < 2; ++half) {
            float bl[8], bb[8];
#pragma unroll
            for (int i = 0; i < 8; ++i) { bl[i] = 0.f; bb[i] = 0.f; }
#pragma unroll
            for (int q4 = 0; q4 < 4; ++q4) {
                const LAS f32x4* qp = (const LAS f32x4*)(lds + GL_QP + (q4 * 128 + c0 + 8 * half) * 4); const f32x4 x0 = qp[0], x1 = qp[1];
#pragma unroll
                for (int i = 0; i < 4; ++i) { bl[i] += x0[i]; bl[4 + i] += x1[i]; if (q4 < tqr) { bb[i] += x0[i]; bb[4 + i] += x1[i]; } }
            }
            { const LAS f32x4* bp = (const LAS f32x4*)(lds + GL_BL + (t2 * 128 + c0 + 8 * half) * 4); const f32x4 x0 = bp[0], x1 = bp[1];
#pragma unroll
              for (int i = 0; i < 4; ++i) { bb[i] += x0[i]; bb[4 + i] += x1[i]; } }
            float qe[8], ke[8], kt[8];
#pragma unroll
            for (int i = 0; i < 8; ++i) { const float qv = bf2f((bf16_t)qc[half][i]), kv = bf2f((bf16_t)kc[half][i]);
                qe[i] = qv * 0.08838834764831845f * __expf(bb[i]); ke[i] = kv * __expf(-bb[i]); kt[i] = kv * __expf(bl[i] - bb[i]); }
            u32x4 wq, wk; wq.x = pk_bf16(qe[0], qe[1]); wq.y = pk_bf16(qe[2], qe[3]); wq.z = pk_bf16(qe[4], qe[5]); wq.w = pk_bf16(qe[6], qe[7]);
            wk.x = pk_bf16(ke[0], ke[1]); wk.y = pk_bf16(ke[2], ke[3]); wk.z = pk_bf16(ke[4], ke[5]); wk.w = pk_bf16(ke[6], ke[7]);
            *(LAS u32x4*)(lds + GL_QE + t2 * 272 + (c0 + 8 * half) * 2) = wq;
            *(LAS u32x4*)(lds + GL_KE + t2 * 272 + (c0 + 8 * half) * 2) = wk;
            *(u32x4*)(Qg + (size_t)(t0 + t2) * 512 + h * 128 + c0 + 8 * half) = wq;
#pragma unroll
            for (int i = 0; i < 8; i += 2) { const unsigned pw = pk_bf16(kt[i], kt[i + 1]);
                *(LAS bf16_t*)(lds + GL_KT + (c0 + 8 * half + i) * 144 + t2 * 2) = (bf16_t)(pw & 0xffffu);
                *(LAS bf16_t*)(lds + GL_KT + (c0 + 8 * half + i + 1) * 144 + t2 * 2) = (bf16_t)(pw >> 16); }
            if (t2 == CT - 1) {
                f32x4 d0, d1;
#pragma unroll
                for (int i = 0; i < 4; ++i) { d0[i] = __expf(bl[i]); d1[i] = __expf(bl[4 + i]); }
                const int c = c0 + 8 * half; float* dp = (float*)(BR + (size_t)(t0 + (c >> 5)) * DM + 512 + h * 256 + 64) + (c & 31);
                *(f32x4*)dp = d0; *(f32x4*)(dp + 4) = d1; }
        }
    }
    LDS_WAIT(); __syncthreads();
#pragma unroll
    for (int i = 0; i < 2; ++i) { const int x = tid + 512 * i, c = x >> 3, j = x & 7;
        const u32x4 v = *(const LAS u32x4*)(lds + GL_KT + c * 144 + j * 16);
        *(u32x4*)(Kg + (size_t)(t0 + (c >> 1)) * 512 + h * 128 + (c & 1) * 64 + j * 8) = v; }
    if (w < 3) {
        const int ti = (w == 0) ? 0 : 1, tj = (w == 2) ? 1 : 0;
        f32x16 c;
#pragma unroll
        for (int i = 0; i < 16; ++i) c[i] = 0.f;
#pragma unroll
        for (int s = 0; s < 8; ++s) {
            const bf16x8 af = *(const LAS bf16x8*)(lds + GL_QE + (32 * ti + r32) * 272 + (16 * s + 8 * hh) * 2);
            const bf16x8 bfr = *(const LAS bf16x8*)(lds + GL_KE + (32 * tj + r32) * 272 + (16 * s + 8 * hh) * 2);
            c = __builtin_amdgcn_mfma_f32_32x32x16_bf16(af, bfr, c, 0, 0, 0);
        }
        const int tcol = 32 * tj + r32;
#pragma unroll
        for (int i = 0; i < 16; i += 2) { const int tr0 = 32 * ti + crow(i, hh), tr1 = tr0 + 1;
            const unsigned pw = pk_bf16(tcol <= tr0 ? c[i] : 0.f, tcol <= tr1 ? c[i + 1] : 0.f);
            *(LAS bf16_t*)(lds + GL_AT + tr0 * 144 + tcol * 2) = (bf16_t)(pw & 0xffffu);
            *(LAS bf16_t*)(lds + GL_AT + tr1 * 144 + tcol * 2) = (bf16_t)(pw >> 16); }
    }
    LDS_WAIT(); __syncthreads();
    { const int t = tid >> 3, j = tid & 7; const u32x4 v = *(const LAS u32x4*)(lds + GL_AT + t * 144 + j * 16);
      *(u32x4*)(BR + (size_t)(t0 + t) * DM + 512 + h * 256 + j * 8) = v; }
}

constexpr int GB_IMG = 41984, GB_KT = 16384, GB_AT = 32768, GB_DEC = 40960, GB_SSQ = 2 * GB_IMG, GB_OST = GB_SSQ + 4096, GB_RST = GB_OST + 32768;
constexpr int GLA_SEGS = 8, GLA_SEG_CH = 8, GLA_NAGG = GLA_SEGS - 1;
template <int MODE>
DI void gla_scan(const Args& a, LAS unsigned char* lds, int b, int h, int seg, float* s_out) {
    const int tid = threadIdx.x, w = __builtin_amdgcn_readfirstlane(tid >> 6), lane = tid & 63, r32 = lane & 31, hh = lane >> 5;
    const bf16_t* Qg = (const bf16_t*)(a.ws + WS_Q); const bf16_t* Kg = (const bf16_t*)(a.ws + WS_K); const bf16_t* VRT = (const bf16_t*)(a.ws + WS_VRT); bf16_t* BR = (bf16_t*)(a.ws + WS_BR);
    float* AGG = (float*)(a.ws + WS_AGG); float* DCUM = (float*)(a.ws + WS_DCUM);
    const int vcol = h * 256 + 32 * w + r32, tok0 = b * 4096 + seg * GLA_SEG_CH * 64, bh = b * 4 + h;
    const bf16_t* vrow = VRT + (size_t)vcol * MTOK; const bf16_t* rrow = VRT + (size_t)(1024 + vcol) * MTOK;
    const float ghead = a.in[17][vcol];
    auto stage = [&](int n) { const int t0 = tok0 + 64 * n; LAS unsigned char* img = lds + (n & 1) * GB_IMG;
        int tl = threadIdx.x; asm volatile("" : "+v"(tl));
        unsigned soQ[2], soA, soD;
#pragma unroll
        for (int i = 0; i < 2; ++i) { const int p = tl + 512 * i, R = p >> 4, q = (p & 15) ^ (R & 15); soQ[i] = (unsigned)(R * 512 + h * 128 + q * 8); }
        { const int p = tl, R = p >> 4, q = (p & 15) ^ (R & 15), t = 2 * R + (q >> 3), j = q & 7; soA = (unsigned)(t * DM + 512 + h * 256 + j * 8); }
        { const int p = tl & 31; soD = (unsigned)((p >> 3) * DM + 512 + h * 256 + 64 + (p & 7) * 8); }
#pragma unroll
        for (int i = 0; i < 2; ++i) {
            if (MODE == 1) __builtin_amdgcn_global_load_lds((const unsigned*)(Qg + (size_t)t0 * 512 + soQ[i]), (LAS unsigned*)(img + (512 * i + 64 * w) * 16), 16, 0, 0);
            __builtin_amdgcn_global_load_lds((const unsigned*)(Kg + (size_t)t0 * 512 + soQ[i]), (LAS unsigned*)(img + GB_KT + (512 * i + 64 * w) * 16), 16, 0, 0); }
        if (MODE == 1) __builtin_amdgcn_global_load_lds((const unsigned*)(BR + (size_t)t0 * DM + soA), (LAS unsigned*)(img + GB_AT + (64 * w) * 16), 16, 0, 0);
        if (w == 0 && lane < 32) __builtin_amdgcn_global_load_lds((const unsigned*)(BR + (size_t)t0 * DM + soD), (LAS unsigned*)(img + GB_DEC), 16, 0, 0); };
    bf16x8 vf[4];
#pragma unroll
    for (int s = 0; s < 4; ++s) vf[s] = *(const bf16x8*)(vrow + tok0 + 16 * s + 8 * hh);
    stage(0);
    f32x16 S[4];
#pragma unroll
    for (int kt = 0; kt < 4; ++kt)
#pragma unroll
        for (int i = 0; i < 16; ++i) S[kt][i] = 0.f;
    if (MODE == 1) {
        for (int j = 0; j < seg; ++j) { const float* ag = AGG + ((size_t)((bh * GLA_NAGG + j) * 8 + w) * 64) * 64 + lane; const float* dc = DCUM + (size_t)(bh * GLA_NAGG + j) * 128;
#pragma unroll
            for (int kt = 0; kt < 4; ++kt)
#pragma unroll
                for (int g = 0; g < 4; ++g) { const f32x4 d = *(const f32x4*)(dc + 32 * kt + 8 * g + 4 * hh);
#pragma unroll
                    for (int e = 0; e < 4; ++e) S[kt][4 * g + e] = S[kt][4 * g + e] * d[e] + ag[(size_t)(kt * 16 + 4 * g + e) * 64]; } }
    }
    float dprod = 1.0f;
    for (int n = 0; n < GLA_SEG_CH; ++n) {
        const int t0 = tok0 + 64 * n; const LAS unsigned char* img = lds + (n & 1) * GB_IMG;
        asm volatile("s_waitcnt vmcnt(0) lgkmcnt(0)" ::: "memory"); __builtin_amdgcn_s_barrier(); asm volatile("" ::: "memory");
        if (n + 1 < GLA_SEG_CH) stage(n + 1);
        bf16x8 vn[4];
        u32x2 rw[8];
        f32x16 op[2];
        if (MODE == 1) {
#pragma unroll
            for (int tt = 0; tt < 2; ++tt) {
                f32x16 c;
#pragma unroll
                for (int i = 0; i < 16; ++i) c[i] = 0.f;
                const int t = 32 * tt + r32;
#pragma unroll
                for (int s = 0; s < 2 * (tt + 1); ++s) { const int R = t >> 1, q = (t & 1) * 8 + 2 * s + hh;
                    const bf16x8 af = *(const LAS bf16x8*)(img + GB_AT + R * 256 + ((q ^ (R & 15)) * 16));
                    c = __builtin_amdgcn_mfma_f32_32x32x16_bf16(af, vf[s], c, 0, 0, 0); }
#pragma unroll
                for (int kt = 0; kt < 4; ++kt)
#pragma unroll
                    for (int s = 0; s < 2; ++s) {
                        u32x4 pw; pw.x = pk_bf16(S[kt][8 * s], S[kt][8 * s + 1]); pw.y = pk_bf16(S[kt][8 * s + 2], S[kt][8 * s + 3]); pw.z = pk_bf16(S[kt][8 * s + 4], S[kt][8 * s + 5]); pw.w = pk_bf16(S[kt][8 * s + 6], S[kt][8 * s + 7]);
                        const bf16x8 sf = __builtin_bit_cast(bf16x8, pw);
                        const int q0 = 4 * kt + 2 * s;
                        const LAS unsigned char* rowp = img + t * 256 + 8 * hh;
                        const s16x4 lo = *(const LAS s16x4*)(rowp + ((q0 ^ (t & 15)) * 16)), hi = *(const LAS s16x4*)(rowp + (((q0 + 1) ^ (t & 15)) * 16));
                        const bf16x8 af = __builtin_shufflevector(lo, hi, 0, 1, 2, 3, 4, 5, 6, 7);
                        c = __builtin_amdgcn_mfma_f32_32x32x16_bf16(af, sf, c, 0, 0, 0);
                        if (s == 1) asm volatile("" ::: "memory");
                    }
                op[tt] = c;
            }
#pragma unroll
            for (int tt = 0; tt < 2; ++tt) {
                float x[16];
#pragma unroll
                for (int i = 0; i < 16; ++i) x[i] = op[tt][i] * op[tt][i];
#pragma unroll
                for (int i = 0; i < 8; ++i) { const bool up = (lane & 16) != 0; const float keep = up ? x[i + 8] : x[i], send = up ? x[i] : x[i + 8]; x[i] = keep + __shfl_xor(send, 16); }
#pragma unroll
                for (int i = 0; i < 4; ++i) { const bool up = (lane & 8) != 0; const float keep = up ? x[i + 4] : x[i], send = up ? x[i] : x[i + 4]; x[i] = keep + __shfl_xor(send, 8); }
#pragma unroll
                for (int i = 0; i < 2; ++i) { const bool up = (lane & 4) != 0; const float keep = up ? x[i + 2] : x[i], send = up ? x[i] : x[i + 2]; x[i] = keep + __shfl_xor(send, 4); }
                { const bool up = (lane & 2) != 0; const float keep = up ? x[1] : x[0], send = up ? x[0] : x[1]; x[0] = keep + __shfl_xor(send, 2); }
                x[0] += __shfl_xor(x[0], 1);
                if ((lane & 1) == 0) { const int reg = (r32 >> 1) & 15; *(LAS float*)(lds + GB_SSQ + (n & 1) * 2048 + (32 * tt + crow(reg, hh)) * 32 + w * 4) = x[0]; }
            }
        } else { if (tid < 128) dprod *= *(const LAS float*)(img + GB_DEC + tid * 4); }
#pragma unroll
        for (int s = 0; s < 4; ++s) vn[s] = (n + 1 < GLA_SEG_CH) ? *(const bf16x8*)(vrow + t0 + 64 + 16 * s + 8 * hh) : vf[s];
        if (MODE == 1) {
#pragma unroll
            for (int i = 0; i < 8; ++i) rw[i] = *(const u32x2*)(rrow + t0 + 32 * (i >> 2) + 8 * (i & 3) + 4 * hh); }
#pragma unroll
        for (int kt = 0; kt < 4; ++kt) {
#pragma unroll
            for (int g = 0; g < 4; ++g) { const f32x4 d = *(const LAS f32x4*)(img + GB_DEC + (32 * kt + 8 * g + 4 * hh) * 4);
#pragma unroll
                for (int e = 0; e < 4; ++e) S[kt][4 * g + e] *= d[e]; }
            const int c = 32 * kt + r32, R = c >> 1;
#pragma unroll
            for (int s = 0; s < 4; ++s) { const int q = (c & 1) * 8 + 2 * s + hh;
                const bf16x8 af = *(const LAS bf16x8*)(img + GB_KT + R * 256 + ((q ^ (R & 15)) * 16));
                S[kt] = __builtin_amdgcn_mfma_f32_32x32x16_bf16(af, vf[s], S[kt], 0, 0, 0); }
            asm volatile("" ::: "memory");
        }
        if (MODE == 1) {
            asm volatile("s_waitcnt lgkmcnt(0)" ::: "memory"); __builtin_amdgcn_s_barrier(); asm volatile("" ::: "memory");
            LAS unsigned char* ost = lds + GB_OST + w * 4096; const LAS unsigned char* sq = lds + GB_SSQ + (n & 1) * 2048; LAS unsigned char* rsw = lds + GB_RST + w * 256;
            { const LAS f32x4* sp = (const LAS f32x4*)(sq + lane * 32); const f32x4 s0 = sp[0], s1 = sp[1];
              const float ss = ((s0[0] + s0[1]) + (s0[2] + s0[3])) + ((s1[0] + s1[1]) + (s1[2] + s1[3]));
              *(LAS float*)(rsw + lane * 4) = 1.0f / sqrtf(ss * (1.0f / 256.0f) + EPS); }
            LDS_WAIT();
#pragma unroll
            for (int tt = 0; tt < 2; ++tt)
#pragma unroll
                for (int g4 = 0; g4 < 4; ++g4) {
                    const int tb = 32 * tt + 8 * g4 + 4 * hh; const u32x2 r2 = rw[tt * 4 + g4];
                    const float rv[4] = {bf_lo(r2.x), bf_hi(r2.x), bf_lo(r2.y), bf_hi(r2.y)};
                    const f32x4 rs4 = *(const LAS f32x4*)(rsw + tb * 4);
#pragma unroll
                    for (int e = 0; e < 4; ++e) { const float val = op[tt][4 * g4 + e] * rs4[e] * ghead * rv[e];
                        *(LAS bf16_t*)(ost + (tb + e) * 64 + r32 * 2) = (bf16_t)(pk_bf16(val, 0.f) & 0xffffu); }
                }
            LDS_WAIT();
#pragma unroll
            for (int i = 0; i < 4; ++i) { const int x = lane + 64 * i, t = x >> 2, part = x & 3; const u32x4 v = *(const LAS u32x4*)(ost + t * 64 + part * 16);
                *(u32x4*)(BR + (size_t)(t0 + t) * DM + 512 + h * 256 + 32 * w + part * 8) = v; }
        }
#pragma unroll
        for (int s = 0; s < 4; ++s) vf[s] = vn[s];
    }
    if (MODE == 1) {
        if (seg == GLA_SEGS - 1) {
#pragma unroll
            for (int kt = 0; kt < 4; ++kt)
#pragma unroll
                for (int i = 0; i < 16; ++i) s_out[(size_t)(32 * kt + crow(i, hh)) * 256 + 32 * w + r32] = S[kt][i]; }
    } else {
        float* ag = AGG + ((size_t)((bh * GLA_NAGG + seg) * 8 + w) * 64) * 64 + lane;
#pragma unroll
        for (int kt = 0; kt < 4; ++kt)
#pragma unroll
            for (int i = 0; i < 16; ++i) ag[(size_t)(kt * 16 + i) * 64] = S[kt][i];
        if (tid < 128) DCUM[(size_t)(bh * GLA_NAGG + seg) * 128 + tid] = dprod;
    }
}

DI void p5_rows(const Args& a, int gw, int NGW, int lane) {
    const bf16_t* Y2 = (const bf16_t*)(a.ws + WS_Y2); const float* SQ = (const float*)(a.ws + WS_SSQ); bf16_t* H2 = (bf16_t*)(a.ws + WS_H2);
    f32x4 ax[8], bx_[8]; u32x2 ay[8], by[8]; float aq = 0.f, bq = 0.f;
    auto issueA = [&](int m) { const float* xr = (m < NPROMPT) ? a.in[0] + (size_t)m * DM : a.in[1] + (size_t)(m - NPROMPT) * DM; const bf16_t* yr = Y2 + (size_t)m * DM;
#pragma unroll
        for (int j = 0; j < 8; ++j) { ax[j] = ((const f32x4*)xr)[lane + 64 * j]; ay[j] = ((const u32x2*)yr)[lane + 64 * j]; }
        aq = (lane < 32) ? SQ[(size_t)m * 32 + lane] : 0.f; };
    auto issueB = [&](int m) { const float* xr = (m < NPROMPT) ? a.in[0] + (size_t)m * DM : a.in[1] + (size_t)(m - NPROMPT) * DM; const bf16_t* yr = Y2 + (size_t)m * DM;
#pragma unroll
        for (int j = 0; j < 8; ++j) { bx_[j] = ((const f32x4*)xr)[lane + 64 * j]; by[j] = ((const u32x2*)yr)[lane + 64 * j]; }
        bq = (lane < 32) ? SQ[(size_t)m * 32 + lane] : 0.f; };
    auto sample_row = [&](int m, f32x4 (&yv)[8]) -> float { const float* pr = (const float*)(a.ws + WS_PART) + (size_t)(m - NPROMPT) * DM; float q = 0.f;
#pragma unroll
        for (int j = 0; j < 8; ++j) { f32x4 t = ((const f32x4*)pr)[lane + 64 * j];
#pragma unroll
            for (int k = 1; k < 4; ++k) t += ((const f32x4*)(pr + (size_t)k * 1024 * DM))[lane + 64 * j];
            yv[j] = t; q += (t.x * t.x + t.y * t.y) + (t.z * t.z + t.w * t.w); }
        return q; };
    auto row = [&](int m, f32x4 (&xv)[8], f32x4 (&yv)[8], float q) {
        if (m >= NPROMPT) q = sample_row(m, yv);
        float* orow = a.out + O_Y + (size_t)m * DM; bf16_t* hr = H2 + (size_t)m * DM;
        const float rstd = 1.0f / sqrtf(wave_sum(q) * (1.f / DM) + EPS);
        float s2 = 0.f;
#pragma unroll
        for (int j = 0; j < 8; ++j) { const f32x4 gg = ((const f32x4*)a.in[24])[lane + 64 * j]; f32x4 t;
            t.x = xv[j].x + yv[j].x * rstd * gg.x; t.y = xv[j].y + yv[j].y * rstd * gg.y; t.z = xv[j].z + yv[j].z * rstd * gg.z; t.w = xv[j].w + yv[j].w * rstd * gg.w;
            xv[j] = t; ((f32x4*)orow)[lane + 64 * j] = t; s2 += (t.x * t.x + t.y * t.y) + (t.z * t.z + t.w * t.w); }
        const float rstd2 = 1.0f / sqrtf(wave_sum(s2) * (1.f / DM) + EPS);
#pragma unroll
        for (int j = 0; j < 8; ++j) { const f32x4 gg = ((const f32x4*)a.in[25])[lane + 64 * j]; u32x2 w; w.x = pk_bf16(xv[j].x * rstd2 * gg.x, xv[j].y * rstd2 * gg.y); w.y = pk_bf16(xv[j].z * rstd2 * gg.z, xv[j].w * rstd2 * gg.w);
            ((u32x2*)hr)[lane + 64 * j] = w; } };
    int m = gw;
    if (m < MTOK) issueA(m);
    if (m + NGW < MTOK) issueB(m + NGW);
    for (; m < MTOK; m += 2 * NGW) {
        { f32x4 xv[8], yv[8]; const float q = aq;
#pragma unroll
          for (int j = 0; j < 8; ++j) { xv[j] = ax[j]; yv[j] = (f32x4){bf_lo(ay[j].x), bf_hi(ay[j].x), bf_lo(ay[j].y), bf_hi(ay[j].y)}; }
          if (m + 2 * NGW < MTOK) issueA(m + 2 * NGW);
          row(m, xv, yv, q); }
        if (m + NGW < MTOK) { f32x4 xv[8], yv[8]; const float q = bq;
#pragma unroll
          for (int j = 0; j < 8; ++j) { xv[j] = bx_[j]; yv[j] = (f32x4){bf_lo(by[j].x), bf_hi(by[j].x), bf_lo(by[j].y), bf_hi(by[j].y)}; }
          if (m + 3 * NGW < MTOK) issueB(m + 3 * NGW);
          row(m + NGW, xv, yv, q); }
    }
}
DI void p9_rows(const Args& a, int gw, int NGW, int lane) {
    const bf16_t* Fb = (const bf16_t*)(a.ws + WS_F); const float* SQ = (const float*)(a.ws + WS_SSQ2);
    f32x4 nx[8]; u32x2 ny[8]; float nq = 0.f;
    auto issue = [&](int m) { const float* xr = a.out + O_Y + (size_t)m * DM; const bf16_t* yr = Fb + (size_t)m * DM;
#pragma unroll
        for (int j = 0; j < 8; ++j) { nx[j] = ((const f32x4*)xr)[lane + 64 * j]; ny[j] = ((const u32x2*)yr)[lane + 64 * j]; }
        nq = (lane < 32) ? SQ[(size_t)m * 32 + lane] : 0.f; };
    auto sample_row = [&](int m, f32x4 (&yv)[8]) -> float { const float* pr = (const float*)(a.ws + WS_PART2) + (size_t)(m - NPROMPT) * DM; float q = 0.f;
#pragma unroll
        for (int j = 0; j < 8; ++j) { f32x4 t = ((const f32x4*)pr)[lane + 64 * j];
#pragma unroll
            for (int k = 1; k < 2; ++k) t += ((const f32x4*)(pr + (size_t)k * 1024 * DM))[lane + 64 * j];
            yv[j] = t; q += (t.x * t.x + t.y * t.y) + (t.z * t.z + t.w * t.w); }
        return q; };
    int m = gw; if (m < MTOK) issue(m);
    for (; m < MTOK; m += NGW) {
        f32x4 xv[8]; f32x4 yv[8]; float q = nq;
#pragma unroll
        for (int j = 0; j < 8; ++j) { xv[j] = nx[j]; yv[j] = (f32x4){bf_lo(ny[j].x), bf_hi(ny[j].x), bf_lo(ny[j].y), bf_hi(ny[j].y)}; }
        if (m >= NPROMPT) q = sample_row(m, yv);
        if (m + NGW < MTOK) issue(m + NGW);
        float* orow = a.out + O_Y + (size_t)m * DM;
        const float rstd = 1.0f / sqrtf(wave_sum(q) * (1.f / DM) + EPS);
#pragma unroll
        for (int j = 0; j < 8; ++j) { const f32x4 gg = ((const f32x4*)a.in[30])[lane + 64 * j]; f32x4 t;
            t.x = xv[j].x + yv[j].x * rstd * gg.x; t.y = xv[j].y + yv[j].y * rstd * gg.y; t.z = xv[j].z + yv[j].z * rstd * gg.z; t.w = xv[j].w + yv[j].w * rstd * gg.w;
            ((f32x4*)orow)[lane + 64 * j] = t; }
    }
}
DI float gelu_tanh(float x) { const float z = 1.5957691216057308f * (x + 0.044715f * x * x * x); return x * __builtin_amdgcn_rcpf(1.0f + __expf(-z)); }
DI void seam_rows(const Args& a, int pm) {
    const float* HEAD = (const float*)(a.ws + WS_HEAD) + (size_t)pm * 2 * F2; const float* TAIL = (const float*)(a.ws + WS_TAIL) + (size_t)(pm - 1) * 2 * F2;
    const float* wdw = a.in[27]; const float* bdw = a.in[28]; bf16_t* HG = (bf16_t*)(a.ws + WS_HG) + (size_t)pm * 256 * FF;
#pragma unroll 2
    for (int i = threadIdx.x; i < 2 * (FF / 4); i += 512) { const int r = i / (FF / 4), f = (i - r * (FF / 4)) * 4;
        const float* a0 = HEAD + (size_t)r * F2; const float* a1 = r ? HEAD : TAIL + F2; const float* a2 = r ? TAIL + F2 : TAIL;
        const f32x4 bg = *(const f32x4*)(bdw + f), bv = *(const f32x4*)(bdw + FF + f);
        const f32x4 g0 = *(const f32x4*)(a0 + f), g1 = *(const f32x4*)(a1 + f), g2 = *(const f32x4*)(a2 + f);
        const f32x4 v0 = *(const f32x4*)(a0 + FF + f), v1 = *(const f32x4*)(a1 + FF + f), v2 = *(const f32x4*)(a2 + FF + f);
        const f32x4 wg0 = *(const f32x4*)(wdw + f), wg1 = *(const f32x4*)(wdw + F2 + f), wg2 = *(const f32x4*)(wdw + 2 * F2 + f);
        const f32x4 wv0 = *(const f32x4*)(wdw + FF + f), wv1 = *(const f32x4*)(wdw + F2 + FF + f), wv2 = *(const f32x4*)(wdw + 2 * F2 + FF + f);
        float h[4];
#pragma unroll
        for (int e = 0; e < 4; ++e) { const float cg = bg[e] + (wg0[e] * g2[e] + wg1[e] * g1[e] + wg2[e] * g0[e]), cv = bv[e] + (wv0[e] * v2[e] + wv1[e] * v1[e] + wv2[e] * v0[e]); h[e] = gelu_tanh(cg) * cv; }
        u32x2 w; w.x = pk_bf16(h[0], h[1]); w.y = pk_bf16(h[2], h[3]);
        *(u32x2*)(HG + (size_t)r * FF + f) = w; }
}

constexpr int WCOPY_WO = 2048, WCOPY_UP = WCOPY_WO + 32 * 352, WCOPY_N = WCOPY_UP + 88 * 64, WCOPY_T1 = 0;
DI void wcopy_items(const Args& a, LAS unsigned char* lds, int i0, int i1, int g, int NG, int wave, int lane) {
    LAS float* scr = (LAS float*)(lds + wave * 16384);
    const float* w_o = as_global(a.in[23]); const float* w_up = as_global(a.in[26]); const float* w_dn = as_global(a.in[29]); unsigned char* ws = as_global(a.ws);
    tr_pipeline([=](int it) -> TrSrc { TrSrc t;
        if (it < WCOPY_WO) { const int kb = it / 64, n0 = (it % 64) * 32; t.src = w_o + (size_t)(kb * 64) * 2048 + n0; t.ldw = 2048; t.dst = (bf16_t*)(ws + WS_WO) + (size_t)n0 * DM + kb * 64; t.dld = DM; }
        else if (it < WCOPY_UP) { const int r = it - WCOPY_WO, kb = r / 352, n0 = (r % 352) * 32; const int part = n0 / FF, jf = n0 % FF, rho = (jf >> 7) * 256 + part * 128 + (jf & 127);
            t.src = w_up + (size_t)(kb * 64) * F2 + n0; t.ldw = F2; t.dst = (bf16_t*)(ws + WS_WUP) + (size_t)rho * DM + kb * 64; t.dld = DM; }
        else { const int r = it - WCOPY_UP, kb = r / 64, n0 = (r % 64) * 32; t.src = w_dn + (size_t)(kb * 64) * 2048 + n0; t.ldw = 2048; t.dst = (bf16_t*)(ws + WS_WDN) + (size_t)n0 * FF + kb * 64; t.dld = FF; }
        return t; }, i0, i1, g, NG, scr, lane);
}

constexpr int PH_P0 = 0, PH_P1 = 1, PH_P2A = 2, PH_P2B = 3, PH_P2C = 4, PH_MERGE = 5, PH_WO = 6, PH_NORM1 = 7, PH_UP = 8, PH_DOWN = 9, PH_FINAL = 10, NPH = 11;
__global__ void __launch_bounds__(512, 2) fwd_kernel(Args args_unused) {
    extern __shared__ __attribute__((aligned(16))) unsigned char lds_raw[];
    LAS unsigned char* lds = (LAS unsigned char*)lds_raw;
    { const unsigned* kp = (const unsigned*)__builtin_amdgcn_kernarg_segment_ptr(); if (threadIdx.x < ARGS_DW) ((LAS unsigned*)(lds + LDSARGS_OFF))[threadIdx.x] = kp[threadIdx.x]; }
    volatile LAS unsigned* MISC = (volatile LAS unsigned*)(lds + MISC_OFF);
    const int tid = threadIdx.x, lane = tid & 63, wave = __builtin_amdgcn_readfirstlane(tid >> 6);
    const int G = gridDim.x, bx = blockIdx.x, vcu = (G % 8 == 0) ? (bx % 8) * (G / 8) + bx / 8 : bx;
    const int gw = vcu * 8 + wave, NGW = G * 8;
    for (int u = tid; u < (MISC_OFF + 128 - LDSCTL_OFF) / 4; u += 512) ((LAS unsigned*)(lds + LDSCTL_OFF))[u] = 0u;
    __syncthreads();
    int lo, hi, li; unsigned char* ws0;
    { const Args a0 = fetch_args(lds); lo = a0.ph_lo; hi = a0.ph_hi; li = a0.li; ws0 = a0.ws; }
    const bool multi = (hi - lo) > 1;
    XcdBarrier bar; bar.bar = (unsigned*)(ws0 + WS_CTL) + CW_BAR + li * XCD_BAR_WORDS; bar.x = 0; bar.st = nullptr;
    if (multi) bar = xcd_barrier_post((unsigned*)(ws0 + WS_CTL) + CW_BAR + li * XCD_BAR_WORDS, MISC + 8);
#define IN(k) (lo <= (k) && (k) < hi)
#define SEAM(k) do { if (IN(k) && IN((k) + 1)) xcd_barrier(bar); } while (0)

    if (IN(PH_P0)) { const Args args = fetch_args<((GMASK >> PH_P0) & 1) != 0>(lds); p0_prologue(args, lds, gw, NGW, wave, lane); }
    SEAM(PH_P0);
    if (IN(PH_P1)) {
        const Args args = fetch_args<((GMASK >> PH_P1) & 1) != 0>(lds); unsigned char* ws = args.ws; bf16_t* RB = (bf16_t*)(ws + WS_RB);
        pg8::Gemm g{RB, RB, DM, DM, DM}; pg8::SchedP1 S{G, bx};
        pg8::EpiP1 E{ws, args.out, args.in[19]};
        pg8::gemm_phase<pg8::EpiP1, pg8::SchedP1>(lds, g, S, E);
    }
    SEAM(PH_P1);
    if (IN(PH_P2A)) {
        const Args args = fetch_args<((GMASK >> PH_P2A) & 1) != 0>(lds); const int h = bx & 3;
        for (int i = tid; i < 16 * 128; i += 512) *(LAS float*)(lds + GL_WG + i * 4) = args.in[15][(size_t)(i >> 7) * 512 + h * 128 + (i & 127)];
        for (int bn = (bx >> 2); bn < 256; bn += (G >> 2)) { gla_prep_chunk(args, lds, (bn >> 6) * 4096 + (bn & 63) * 64, h); }
        constexpr int N_MA = 2048, N_PL = MTOK / 8;
        if (NGW == N_MA) { mem_attn_wg(args, lds, gw, lane);
            for (int it = N_MA + gw; it < N_MA + N_PL; it += NGW) pool_item(args, it - N_MA, lane); }
        else for (int it = gw; it < N_MA + N_PL; it += NGW) { if (it < N_MA) mem_attn_item(args, it, lane); else pool_item(args, it - N_MA, lane); }
    }
    SEAM(PH_P2A);
    if (IN(PH_P2B)) {
        const Args args = fetch_args<((GMASK >> PH_P2B) & 1) != 0>(lds);
        if (bx < 16 * GLA_NAGG) { gla_scan<0>(args, lds, (bx >> 2) & 3, bx & 3, bx >> 4, nullptr); }
        else {
            if (bx < 240) { const int it = bx - 112; gla_sequence<32>(args, lds, NPROMPT + (it >> 2) * 32, 1, it & 3, args.in[4] + (size_t)it * 128 * 256, args.out + O_GLAS + (size_t)it * 128 * 256); __syncthreads(); }
            if (bx < 240) { mem_attn_wg_sample(args, lds, bx - 112, wave, lane); __syncthreads(); }
            wcopy_items(args, lds, 0, WCOPY_T1, (bx - 112) * 8 + wave, (G - 112) * 8, wave, lane);
        }
    }
    SEAM(PH_P2B);
    if (IN(PH_P2C)) {
        const Args args = fetch_args<((GMASK >> PH_P2C) & 1) != 0>(lds); unsigned char* ws = args.ws;
        if (bx < 16 * GLA_SEGS) { const int bh = bx & 15; gla_scan<1>(args, lds, bh >> 2, bh & 3, bx >> 4, args.out + O_GLAP + (size_t)bh * 128 * 256); }
        else if (bx < 160) {
            pg8::Gemm g{(const bf16_t*)(ws + WS_BR), (const bf16_t*)(ws + WS_WB), DM, DM, DM}; pg8::SchedOne S{64 + ((bx - 128) >> 3), (bx - 128) & 7, 32};
            pg8::EpiMerge E{ws};
            pg8::gemm_phase<pg8::EpiMerge, pg8::SchedOne>(lds, g, S, E);
        }
        else wcopy_items(args, lds, WCOPY_T1, WCOPY_N, (bx - 160) * 8 + wave, (G - 160) * 8, wave, lane);
    }
    SEAM(PH_P2C);
    if (IN(PH_MERGE)) {
        const Args args = fetch_args<((GMASK >> PH_MERGE) & 1) != 0>(lds); unsigned char* ws = args.ws;
        pg8::Gemm g{(const bf16_t*)(ws + WS_BR), (const bf16_t*)(ws + WS_WB), DM, DM, DM}; pg8::Sched2D S{64, 8, G, bx, 0, 0, 32};
        pg8::EpiMerge E{ws};
        pg8::gemm_phase<pg8::EpiMerge, pg8::Sched2D>(lds, g, S, E);
    }
    SEAM(PH_MERGE);
    if (IN(PH_WO)) {
        const Args args = fetch_args<((GMASK >> PH_WO) & 1) != 0>(lds); unsigned char* ws = args.ws;
        pg8::Gemm g{(const bf16_t*)(ws + WS_MG), (const bf16_t*)(ws + WS_WO), DM, DM, DM}; pg8::SchedTail S{G, bx, 32, 128};
        pg8::EpiNorm E{(bf16_t*)(ws + WS_Y2), (float*)(ws + WS_SSQ), (float*)(ws + WS_PART)};
        pg8::gemm_phase<pg8::EpiNorm, pg8::SchedTail>(lds, g, S, E);
    }
    SEAM(PH_WO);
    if (IN(PH_NORM1)) {
        const Args args = fetch_args<((GMASK >> PH_NORM1) & 1) != 0>(lds); unsigned char* ws = args.ws;
        p5_rows(args, gw, NGW, lane);
    }
    SEAM(PH_NORM1);
    if (IN(PH_UP)) {
        const Args args = fetch_args<((GMASK >> PH_UP) & 1) != 0>(lds); unsigned char* ws = args.ws;
        pg8::Gemm g{(const bf16_t*)(ws + WS_H2), (const bf16_t*)(ws + WS_WUP), DM, DM, DM}; pg8::SchedUp S{G, bx};
        pg8::EpiUpConv E{ws, args.out, args.in[27], args.in[28], args.in[5], lds};
        pg8::gemm_phase<pg8::EpiUpConv, pg8::SchedUp>(lds, g, S, E);
        if (G - 1 - bx < 64) {
            if (tid == 0) { unsigned* cnt = (unsigned*)(ws + WS_CTL) + CW_UPDONE; unsigned* bw = (unsigned*)(ws + WS_CTL) + CW_BAR;
                for (int p = 0; p < 4; ++p) XB_SPIN(xb_ld(cnt + p * 32) < 44u, bw);
                __builtin_amdgcn_fence(__ATOMIC_ACQUIRE, "agent"); }
            __syncthreads();
            pg8::Gemm g2{(const bf16_t*)(ws + WS_HG), (const bf16_t*)(ws + WS_WDN), FF, FF, FF}; pg8::SchedPieces S2{G, bx};
            pg8::EpiNorm E2{(bf16_t*)(ws + WS_F), (float*)(ws + WS_SSQ2), (float*)(ws + WS_PART2)};
            pg8::gemm_phase<pg8::EpiNorm, pg8::SchedPieces>(lds, g2, S2, E2);
        }
    }
    SEAM(PH_UP);
    if (IN(PH_DOWN)) {
        const Args args = fetch_args<((GMASK >> PH_DOWN) & 1) != 0>(lds); unsigned char* ws = args.ws;
        pg8::SchedTail S{G, bx, 88, 0};
        { pg8::Unit u; for (int i = 0; S.next(i, u); ++i) if (u.om < 64 && (u.om & 15) != 0) seam_rows(args, u.om); }
        asm volatile("s_waitcnt vmcnt(0)" ::: "memory"); __syncthreads();
        pg8::Gemm g{(const bf16_t*)(ws + WS_HG), (const bf16_t*)(ws + WS_WDN), FF, FF, FF};
        pg8::EpiNorm E{(bf16_t*)(ws + WS_F), (float*)(ws + WS_SSQ2), (float*)(ws + WS_PART2)};
        pg8::gemm_phase<pg8::EpiNorm, pg8::SchedTail>(lds, g, S, E);
    }
    SEAM(PH_DOWN);
    if (IN(PH_FINAL)) { const Args args = fetch_args<((GMASK >> PH_FINAL) & 1) != 0>(lds); p9_rows(args, gw, NGW, lane); }
#undef IN
#undef SEAM
}

#ifndef MK_PER_PHASE
#define MK_PER_PHASE 0
#endif
extern "C" void kernel_launch(void* const* d_in, const int* in_sizes, int n_in, void* d_out, int out_size, void* d_ws, size_t ws_size, hipStream_t stream) {
    static int grid = 0;
    if (grid == 0) {
        if (n_in != 31 || in_sizes[0] != NPROMPT * DM || out_size != (int)O_TOTAL || ws_size < WS_END) {
            fprintf(stderr, "kernel_launch: unexpected shapes: n_in %d in0 %d out %d ws %zu (need %zu)\n", n_in, n_in > 0 ? in_sizes[0] : -1, out_size, ws_size, (size_t)WS_END); grid = -1; return; }
        int dev = 0, cus = 0;
        if (hipGetDevice(&dev) != hipSuccess || hipDeviceGetAttribute(&cus, hipDeviceAttributeMultiprocessorCount, dev) != hipSuccess) { grid = -1; return; }
        if (hipFuncSetAttribute((const void*)fwd_kernel, hipFuncAttributeMaxDynamicSharedMemorySize, LDS_BYTES) != hipSuccess) { fprintf(stderr, "kernel_launch: hipFuncSetAttribute failed\n"); grid = -1; return; }
        int per_cu = 0;
        if (hipOccupancyMaxActiveBlocksPerMultiprocessor(&per_cu, (const void*)fwd_kernel, 512, LDS_BYTES) != hipSuccess || per_cu < 1) fprintf(stderr, "kernel_launch: occupancy query reports %d\n", per_cu);
        (void)hipGetLastError();
        grid = cus;
    }
    if (grid < 0) return;
    if (hipMemsetAsync((char*)d_ws + WS_CTL, 0, CTL_ZERO_BYTES, stream) != hipSuccess) return;
    Args a{};
    for (int i = 0; i < 31; ++i) a.in[i] = (const float*)d_in[i];
    a.out = (float*)d_out; a.ws = (unsigned char*)d_ws;
#if MK_PER_PHASE
    for (int p = 0; p < NPH; ++p) { a.ph_lo = p; a.ph_hi = p + 1; a.li = 0; hipLaunchKernelGGL(fwd_kernel, dim3(grid), dim3(512), LDS_BYTES, stream, a); }
#else
    a.ph_lo = 0; a.ph_hi = NPH; a.li = 0;
    hipLaunchKernelGGL(fwd_kernel, dim3(grid), dim3(512), LDS_BYTES, stream, a);
#endif
}
```
